# Optimizing an MI355X kernel written in HIP

```python
import math
import jax, jax.numpy as jnp
from jax import lax
import numpy as np

D_MODEL = 1024
BATCH = 16
SEQ = 4096
DEPTH = 2
DEC_BATCH = 8
DEC_SEQ = 64
PAST_LEN = 1024

CHUNK = 64
N_AB = (DEPTH + 1) // 2
N_CD = DEPTH // 2
RMS_EPS = 1e-5
LN_EPS = 1e-5
A_WIDTH = D_MODEL // 2
A_CONV = 3
B_WIDTH = D_MODEL // 2
B_GROUPS = 4
B_GROUP_DIM = B_WIDTH // B_GROUPS
B_CHUNK = 128
C_HEADS = 8
C_HEAD_DIM = 64
C_WIDTH = C_HEADS * C_HEAD_DIM
C_PREV_CHUNKS = 8
C_BAND = C_PREV_CHUNKS * CHUNK
C_KEYS = C_BAND + CHUNK
C_MAX_REL = 128
D_HEADS = 8
D_HEAD_DIM = 64
D_INNER = D_HEADS * D_HEAD_DIM
D_GROUPS = 2
D_STATE = 128
D_CONV = 4
D_XBC = D_INNER + 2 * D_GROUPS * D_STATE
DT_MIN = 0.001
DT_MAX = 0.1
AB_IN = 3 * A_WIDTH + 2 * B_WIDTH
CD_IN = 3 * C_WIDTH + D_INNER + D_XBC + D_HEADS
MIX_WIDTH = A_WIDTH + B_WIDTH
FFN_HIDDEN = -(-(8 * D_MODEL) // (3 * 256)) * 256

kernel_name = 'hybrid_streaming_encoder_step'

F32 = jnp.float32


def rmsnorm(x, g):
    xf = x.astype(F32)
    y = xf * lax.rsqrt(jnp.mean(xf * xf, axis=-1, keepdims=True) + RMS_EPS)
    return (y * g.astype(F32)).astype(x.dtype)


def layernorm(x, g, b):
    xf = x.astype(F32)
    mu = jnp.mean(xf, axis=-1, keepdims=True)
    xc = xf - mu
    var = jnp.mean(xc * xc, axis=-1, keepdims=True)
    return (xc * lax.rsqrt(var + LN_EPS) * g.astype(F32) + b.astype(F32)).astype(x.dtype)


def swiglu(x, wg, wu, wd):
    return (jax.nn.silu(x @ wg) * (x @ wu)) @ wd


def causal_dwconv(u_ext, w):
    width = w.shape[0]
    L = u_ext.shape[1] - (width - 1)
    return sum(w[k] * u_ext[:, k:k + L] for k in range(width))


def mixer_a(xa, gate_b, gate_c, conv_hist, conv_w):
    u = gate_c * xa
    u_ext = jnp.concatenate([conv_hist.astype(u.dtype), u], axis=1)
    y = gate_b * causal_dwconv(u_ext, conv_w)
    return y, u_ext[:, -(A_CONV - 1):]


def mixer_b(u, v, ln_g, ln_b, w_s, b_s):
    b, L, _ = u.shape
    blk = min(L, B_CHUNK)
    n = L // blk
    v = layernorm(v, ln_g, ln_b)
    tri = jnp.tril(jnp.ones((blk, blk), dtype=bool))
    w = jnp.where(tri[None], w_s[:, :blk, :blk], 0)
    vb = v.reshape(b, n, blk, B_GROUPS, B_GROUP_DIM)
    f = jnp.einsum('gts,bnsgc->bntgc', w, vb) + b_s[:, :blk].T[None, None, :, :, None]
    return u * f.reshape(b, L, B_WIDTH), v


def ab_layer(h, conv_hist, w_in, conv_w, ln_g, ln_b, w_s, b_s, w_out):
    proj = h @ w_in
    xa, gate_b, gate_c, u, v = jnp.split(
        proj, [A_WIDTH, 2 * A_WIDTH, 3 * A_WIDTH, 3 * A_WIDTH + B_WIDTH], axis=-1)
    ya, new_hist = mixer_a(xa, gate_b, gate_c, conv_hist, conv_w)
    yb, v_rows = mixer_b(jax.nn.gelu(u, approximate=False), jax.nn.gelu(v, approximate=False),
                         ln_g, ln_b, w_s, b_s)
    return jnp.concatenate([ya, yb], axis=-1) @ w_out, new_hist, v_rows


def rel_bias_gather(table, q_pos, k_pos):
    rel = jnp.clip(q_pos[:, None] - k_pos[None, :], -C_MAX_REL, C_MAX_REL) + C_MAX_REL
    return table[:, rel]


def attn_core(q, k, v, bias, mask):
    s = jnp.einsum('bqhd,bkhd->bhqk', q.astype(F32), k.astype(F32)) * (C_HEAD_DIM ** -0.5)
    s = s + bias.astype(F32)[None]
    if mask is not None:
        s = jnp.where(mask, s, -1e30)
    p = jax.nn.softmax(s, axis=-1)
    return jnp.einsum('bhqk,bkhd->bqhd', p, v.astype(F32)).astype(q.dtype)


def mixer_c_prompt(q, k, v, table):
    b, L, H, dh = q.shape
    nc = L // CHUNK
    pad = ((0, 0), (C_BAND, 0), (0, 0), (0, 0))
    kp = jnp.pad(k, pad)
    vp = jnp.pad(v, pad)
    kj = jnp.arange(C_KEYS)
    bias = rel_bias_gather(table, jnp.arange(CHUNK) + C_BAND, kj)

    def one_chunk(c):
        start = c * CHUNK
        qc = lax.dynamic_slice_in_dim(q, start, CHUNK, axis=1)
        kc = lax.dynamic_slice_in_dim(kp, start, C_KEYS, axis=1)
        vc = lax.dynamic_slice_in_dim(vp, start, C_KEYS, axis=1)
        mask = (start - C_BAND + kj >= 0)[None, :]
        return attn_core(qc, kc, vc, bias, mask)

    out = lax.map(one_chunk, jnp.arange(nc))
    out = jnp.moveaxis(out, 0, 1).reshape(b, L, H * dh)
    keep = min(C_BAND, L)
    return out, k[:, L - keep:], v[:, L - keep:]


def mixer_c_sample(q, k, v, cache_k, cache_v, table):
    b, T, H, dh = q.shape
    Lc = cache_k.shape[1]
    kk = jnp.concatenate([cache_k.astype(k.dtype), k], axis=1)
    vv = jnp.concatenate([cache_v.astype(v.dtype), v], axis=1)
    bias = rel_bias_gather(table, Lc + jnp.arange(T), jnp.arange(Lc + T))
    out = attn_core(q, kk, vv, bias, None)
    return out.reshape(b, T, H * dh)


def ssd(x, dt, A, Bm, Cm, h0, q_len):
    b, L, H, P = x.shape
    nc = L // q_len
    Hg = H // D_GROUPS
    xs = x.astype(F32).reshape(b, nc, q_len, D_GROUPS, Hg, P)
    dts = dt.astype(F32).reshape(b, nc, q_len, D_GROUPS, Hg)
    Bs = Bm.astype(F32).reshape(b, nc, q_len, D_GROUPS, D_STATE)
    Cs = Cm.astype(F32).reshape(b, nc, q_len, D_GROUPS, D_STATE)
    cum = jnp.cumsum(dts * A.astype(F32).reshape(D_GROUPS, Hg), axis=2)
    tri = jnp.tril(jnp.ones((q_len, q_len), dtype=bool))[:, :, None, None]
    seg = cum[:, :, :, None] - cum[:, :, None, :]
    decay = jnp.exp(jnp.where(tri, seg, -jnp.inf))
    xdt = xs * dts[..., None]
    cb = jnp.einsum('bctgn,bcsgn->bctsg', Cs, Bs)
    y_intra = jnp.einsum('bctsgh,bcsghp->bctghp', cb[..., None] * decay, xdt)
    decay_end = jnp.exp(cum[:, :, -1:] - cum)
    states = jnp.einsum('bcsgn,bcsghp->bcghpn', Bs, xdt * decay_end[..., None])
    chunk_decay = jnp.exp(cum[:, :, -1])

    def step(h, inp):
        dec, st = inp
        return dec[..., None, None] * h + st, h

    h_init = h0.astype(F32).reshape(b, D_GROUPS, Hg, P, D_STATE)
    h_last, h_in = lax.scan(step, h_init,
                            (jnp.moveaxis(chunk_decay, 1, 0), jnp.moveaxis(states, 1, 0)))
    h_in = jnp.moveaxis(h_in, 0, 1)
    y_inter = jnp.einsum('bctgn,bcghpn->bctghp', Cs, h_in) * jnp.exp(cum)[..., None]
    y = (y_intra + y_inter).reshape(b, L, H, P)
    return y, h_last.reshape(b, H, P, D_STATE).astype(h0.dtype)


def mixer_d(z, xbc, dt_raw, conv_hist, conv_w, conv_b, dt_bias, a_log, d_skip, norm_g, h0, q_len):
    b, L, _ = xbc.shape
    xbc_ext = jnp.concatenate([conv_hist.astype(xbc.dtype), xbc], axis=1)
    xbc_c = jax.nn.silu(causal_dwconv(xbc_ext, conv_w) + conv_b)
    new_hist = xbc_ext[:, -(D_CONV - 1):]
    gn = D_GROUPS * D_STATE
    xh = xbc_c[..., :D_INNER].reshape(b, L, D_HEADS, D_HEAD_DIM)
    Bm = xbc_c[..., D_INNER:D_INNER + gn].reshape(b, L, D_GROUPS, D_STATE)
    Cm = xbc_c[..., D_INNER + gn:].reshape(b, L, D_GROUPS, D_STATE)
    dt = jax.nn.softplus(dt_raw.astype(F32) + dt_bias.astype(F32))
    A = -jnp.exp(a_log.astype(F32))
    y, h = ssd(xh, dt, A, Bm, Cm, h0, q_len)
    y = y + d_skip.astype(F32)[:, None] * xh.astype(F32)
    y = y.reshape(b, L, D_INNER) * jax.nn.silu(z.astype(F32))
    yg = y.reshape(b, L, D_GROUPS, D_INNER // D_GROUPS)
    yg = yg * lax.rsqrt(jnp.mean(yg * yg, axis=-1, keepdims=True) + RMS_EPS)
    y = yg.reshape(b, L, D_INNER) * norm_g.astype(F32)
    return y.astype(z.dtype), new_hist, h


def cd_split(h, w_in):
    b, L, _ = h.shape
    proj = h @ w_in
    q, k, v, z, xbc, dt_raw = jnp.split(
        proj, [C_WIDTH, 2 * C_WIDTH, 3 * C_WIDTH, 3 * C_WIDTH + D_INNER,
               3 * C_WIDTH + D_INNER + D_XBC], axis=-1)
    shp = (b, L, C_HEADS, C_HEAD_DIM)
    return q.reshape(shp), k.reshape(shp), v.reshape(shp), z, xbc, dt_raw


def setup_inputs(seed: int = 0) -> dict:
    key = jax.random.key(seed)
    ks = jax.random.split(key, 32)

    def nrm(i, shape, scale):
        return scale * jax.random.normal(ks[i], shape, jnp.float32)

    c_len = min(C_BAND, PAST_LEN)
    u = jax.random.uniform(ks[21], (N_CD, D_HEADS), jnp.float32)
    dt0 = jnp.exp(u * (math.log(DT_MAX) - math.log(DT_MIN)) + math.log(DT_MIN))
    dt_bias = dt0 + jnp.log(-jnp.expm1(-dt0))
    a_log = jnp.log(jax.random.uniform(ks[22], (N_CD, D_HEADS), jnp.float32, 1.0, 16.0))
    return {
        'x_prompt': nrm(0, (BATCH, SEQ, D_MODEL), 1.0),
        'x_sample': nrm(1, (DEC_BATCH, DEC_SEQ, D_MODEL), 1.0),
        'cache_k_c': nrm(2, (N_CD, DEC_BATCH, c_len, C_HEADS, C_HEAD_DIM), 1.0),
        'cache_v_c': nrm(3, (N_CD, DEC_BATCH, c_len, C_HEADS, C_HEAD_DIM), 1.0),
        'state_conv_a': nrm(4, (N_AB, DEC_BATCH, A_CONV - 1, A_WIDTH), 1.0),
        'state_conv_d': nrm(5, (N_CD, DEC_BATCH, D_CONV - 1, D_XBC), 1.0),
        'state_ssm_d': nrm(6, (N_CD, DEC_BATCH, D_HEADS, D_HEAD_DIM, D_STATE), 0.1),
        'norm_mix': 1.0 + nrm(7, (DEPTH, D_MODEL), 0.1),
        'norm_ffn': 1.0 + nrm(8, (DEPTH, D_MODEL), 0.1),
        'norm_final': 1.0 + nrm(9, (D_MODEL,), 0.1),
        'w_in_ab': nrm(10, (N_AB, D_MODEL, AB_IN), D_MODEL ** -0.5),
        'conv_w_a': nrm(11, (N_AB, A_CONV, A_WIDTH), A_CONV ** -0.5),
        'ln_g_b': 1.0 + nrm(12, (N_AB, B_WIDTH), 0.1),
        'ln_b_b': nrm(13, (N_AB, B_WIDTH), 0.02),
        'w_s_b': nrm(14, (N_AB, B_GROUPS, B_CHUNK, B_CHUNK), B_CHUNK ** -0.5),
        'b_s_b': 1.0 + nrm(15, (N_AB, B_GROUPS, B_CHUNK), 0.1),
        'w_out_ab': nrm(16, (N_AB, MIX_WIDTH, D_MODEL), MIX_WIDTH ** -0.5),
        'w_in_cd': nrm(17, (N_CD, D_MODEL, CD_IN), D_MODEL ** -0.5),
        'rel_bias_c': nrm(18, (N_CD, C_HEADS, 2 * C_MAX_REL + 1), 0.5),
        'conv_w_d': nrm(19, (N_CD, D_CONV, D_XBC), D_CONV ** -0.5),
        'conv_b_d': nrm(20, (N_CD, D_XBC), 0.02),
        'dt_bias_d': dt_bias,
        'a_log_d': a_log,
        'd_skip_d': 1.0 + nrm(23, (N_CD, D_HEADS), 0.1),
        'norm_g_d': 1.0 + nrm(24, (N_CD, D_INNER), 0.1),
        'w_out_cd': nrm(25, (N_CD, MIX_WIDTH, D_MODEL), MIX_WIDTH ** -0.5),
        'w_gate': nrm(26, (DEPTH, D_MODEL, FFN_HIDDEN), D_MODEL ** -0.5),
        'w_up': nrm(27, (DEPTH, D_MODEL, FFN_HIDDEN), D_MODEL ** -0.5),
        'w_down': nrm(28, (DEPTH, FFN_HIDDEN, D_MODEL), FFN_HIDDEN ** -0.5),
    }


def reference(x_prompt, x_sample, cache_k_c, cache_v_c, state_conv_a, state_conv_d, state_ssm_d,
              norm_mix, norm_ffn, norm_final, w_in_ab, conv_w_a, ln_g_b, ln_b_b, w_s_b, b_s_b,
              w_out_ab, w_in_cd, rel_bias_c, conv_w_d, conv_b_d, dt_bias_d, a_log_d, d_skip_d,
              norm_g_d, w_out_cd, w_gate, w_up, w_down):
    hp, hs = x_prompt, x_sample
    bp, Lp, _ = hp.shape
    bs, Ls, _ = hs.shape
    conv_a_p, conv_a_s, v_b_s = [], [], []
    k_c_p, v_c_p, k_c_s, v_c_s = [], [], [], []
    conv_d_p, conv_d_s, ssm_d_p, ssm_d_s = [], [], [], []
    for layer in range(DEPTH):
        i = layer // 2
        hp_n = rmsnorm(hp, norm_mix[layer])
        hs_n = rmsnorm(hs, norm_mix[layer])
        if layer % 2 == 0:
            w = (w_in_ab[i], conv_w_a[i], ln_g_b[i], ln_b_b[i], w_s_b[i], b_s_b[i], w_out_ab[i])
            zero_hist = jnp.zeros((bp, A_CONV - 1, A_WIDTH), hp.dtype)
            mp, hist_p, _ = ab_layer(hp_n, zero_hist, *w)
            ms, hist_s, vrows_s = ab_layer(hs_n, state_conv_a[i], *w)
            conv_a_p.append(hist_p)
            conv_a_s.append(hist_s)
            v_b_s.append(vrows_s)
        else:
            dw = (conv_w_d[i], conv_b_d[i], dt_bias_d[i], a_log_d[i], d_skip_d[i], norm_g_d[i])
            q, k, v, z, xbc, dt_raw = cd_split(hp_n, w_in_cd[i])
            ap, kkeep, vkeep = mixer_c_prompt(q, k, v, rel_bias_c[i])
            dp, dhist_p, ssm_p = mixer_d(
                z, xbc, dt_raw, jnp.zeros((bp, D_CONV - 1, D_XBC), hp.dtype), *dw,
                jnp.zeros((bp, D_HEADS, D_HEAD_DIM, D_STATE), hp.dtype), CHUNK)
            mp = jnp.concatenate([ap, dp], axis=-1) @ w_out_cd[i]
            q, k, v, z, xbc, dt_raw = cd_split(hs_n, w_in_cd[i])
            a_s = mixer_c_sample(q, k, v, cache_k_c[i], cache_v_c[i], rel_bias_c[i])
            ds, dhist_s, ssm_s = mixer_d(z, xbc, dt_raw, state_conv_d[i], *dw, state_ssm_d[i], Ls)
            ms = jnp.concatenate([a_s, ds], axis=-1) @ w_out_cd[i]
            k_c_p.append(kkeep)
            v_c_p.append(vkeep)
            k_c_s.append(k)
            v_c_s.append(v)
            conv_d_p.append(dhist_p)
            conv_d_s.append(dhist_s)
            ssm_d_p.append(ssm_p)
            ssm_d_s.append(ssm_s)
        hp = hp + mp
        hs = hs + ms
        hp = hp + swiglu(rmsnorm(hp, norm_ffn[layer]), w_gate[layer], w_up[layer], w_down[layer])
        hs = hs + swiglu(rmsnorm(hs, norm_ffn[layer]), w_gate[layer], w_up[layer], w_down[layer])
    y_prompt = rmsnorm(hp, norm_final)
    y_sample = rmsnorm(hs, norm_final)
    new_conv_a_prompt = jnp.stack(conv_a_p)
    new_conv_a_sample = jnp.stack(conv_a_s)
    new_v_b_sample = jnp.stack(v_b_s)
    new_k_c_prompt = jnp.stack(k_c_p)
    new_v_c_prompt = jnp.stack(v_c_p)
    new_k_c_sample = jnp.stack(k_c_s)
    new_v_c_sample = jnp.stack(v_c_s)
    new_conv_d_prompt = jnp.stack(conv_d_p)
    new_conv_d_sample = jnp.stack(conv_d_s)
    new_ssm_d_prompt = jnp.stack(ssm_d_p)
    new_ssm_d_sample = jnp.stack(ssm_d_s)
    return (y_prompt, y_sample, new_conv_a_prompt, new_conv_a_sample, new_v_b_sample,
            new_k_c_prompt, new_v_c_prompt, new_k_c_sample, new_v_c_sample,
            new_conv_d_prompt, new_conv_d_sample, new_ssm_d_prompt, new_ssm_d_sample)
```

```cpp
#define PER_PHASE_LAUNCH 0
#include <hip/hip_runtime.h>
#include <hip/hip_cooperative_groups.h>
#include <cstdio>
namespace cg = cooperative_groups;
#ifndef PER_PHASE_LAUNCH
#define PER_PHASE_LAUNCH 0
#endif
namespace pg8 {
#define PG8_LAS __attribute__((address_space(3)))
typedef unsigned short bf16_t;
typedef short bf16x8 __attribute__((ext_vector_type(8)));
typedef float f32x4 __attribute__((ext_vector_type(4)));
typedef unsigned u32x4 __attribute__((ext_vector_type(4)));
constexpr int BM = 256, BK = 64, HALF = 128, HTB = HALF * BK * 2  , STAGE_BYTES = 8 * HTB, NXCD = 8, WGM = 8;

__host__ __device__ __forceinline__ int lds_byte(int r, int c) { const int st = (r >> 4) * 2 + (c >> 5), rr = r & 15, cc = c & 31, ob = rr * 64 + cc * 2; return st * 1024 + (ob ^ (((ob >> 9) & 1) << 5)); }
__host__ __device__ __forceinline__ void stage_rc(int b, int& R, int& C) { const int st = b / 1024, sb = b % 1024, swz = sb ^ (((sb >> 9) & 1) << 5); R = (st >> 1) * 16 + swz / 64; C = (st & 1) * 32 + (swz % 64) / 2; }
__host__ __device__ __forceinline__ int perm32(int rho) { const int n = rho >> 4, i = rho & 15; return 8 * (i >> 2) + 4 * n + (i & 3); }

struct Unit { int pm, pn; };
struct Gemm { const bf16_t* A; const bf16_t* Bt; int M, N, K; };

struct StaticOrder {
    int nM, nN, nwg, G, c;
    __host__ __device__ void init(int M, int N, int G_, int c_) { nM = M / BM; nN = N / BM; nwg = nM * nN; G = G_; c = c_; }
    __host__ __device__ bool next(int i, Unit& u) const {
        const long L = (long)i * G + c; if (L >= nwg) return false;
        int wgid = (int)L; { const int q = nwg / NXCD, r = nwg % NXCD, xcd = wgid % NXCD, off = wgid / NXCD; wgid = (xcd < r ? xcd * (q + 1) : r * (q + 1) + (xcd - r) * q) + off; }
        const int nig = WGM * nN, gid = wgid / nig, fm = gid * WGM, gsz = (nM - fm) < WGM ? (nM - fm) : WGM;
        u.pm = fm + ((wgid % nig) % gsz); u.pn = (wgid % nig) / gsz; return true;
    }
    __device__ __forceinline__ void a_ready(const Unit&) const {}
    __device__ __forceinline__ void done(const Unit&) const {}
};
__device__ __forceinline__ unsigned cvt_pk_bf16(float lo, float hi) { unsigned r; asm volatile("v_cvt_pk_bf16_f32 %0, %1, %2" : "=v"(r) : "v"(lo), "v"(hi)); return r; }
typedef float f32x2 __attribute__((ext_vector_type(2)));
__device__ __forceinline__ f32x2 gelu_pk(f32x2 v) {
    const f32x2 av = __builtin_elementwise_abs(v), d = av * 0.2316418882f + 1.0f;
    f32x2 t; t.x = __builtin_amdgcn_rcpf(d.x); t.y = __builtin_amdgcn_rcpf(d.y);
    f32x2 q = t * 0.5307027145f + (-0.7265760135f); q = q * t + 0.7107068705f; q = q * t + (-0.142248368f); q = q * t + 0.127414796f; q = q * t;
    const f32x2 s = (v * v) * (-0.72134752044f);
    f32x2 e; e.x = __builtin_amdgcn_exp2f(s.x); e.y = __builtin_amdgcn_exp2f(s.y);
    const f32x2 m = v * (q * e), r = v - m;
    f32x2 o; o.x = v.x < 0.f ? m.x : r.x; o.y = v.y < 0.f ? m.y : r.y; return o;
}
template <class Epi, class Sched, bool STAMP = false>
__device__ __forceinline__ void gemm_phase(PG8_LAS unsigned char* lds, const Gemm g, const Sched& S, const Epi& E, unsigned long long* stamps) {
    int tid_l = threadIdx.x; asm volatile("" : "+v"(tid_l)); const int tid = tid_l, wid = __builtin_amdgcn_readfirstlane(tid >> 6), lane = tid & 63, wr = wid >> 2, wc = wid & 3, fr = lane & 15, fq = lane >> 4;
    const int K = g.K, nt = K / BK;
    int ts_lo = 0, ts_hi = 0, nts = 0; const unsigned long long rt_entry = STAMP ? (unsigned long long)wall_clock64() : 0ull;
#define PG8_STAMP() do { if (STAMP && wid == 0 && nts < 64) { const unsigned long long _c = (unsigned long long)clock64(); \
        ts_lo = (lane == nts) ? (int)(unsigned)_c : ts_lo; ts_hi = (lane == nts) ? (int)(unsigned)(_c >> 32) : ts_hi; ++nts; } } while (0)
    PG8_STAMP();
    unsigned voffA[2], voffB[2];
#pragma unroll
    for (int i = 0; i < 2; ++i) { int R, C; stage_rc(tid * 16 + i * 8192, R, C); const int Rb = Epi::PERM ? ((R & ~31) + perm32(R & 31)) : R;
        voffA[i] = (unsigned)(R * K + C) * 2u; voffB[i] = (unsigned)(Rb * K + C) * 2u; }
    const size_t kstep = (size_t)(BK * 2);
    const size_t hstep = (size_t)HALF * K * 2;
    const size_t tstep = 2 * hstep;
    const unsigned ldsw = (unsigned)wid * 1024u;
    const int aoff = lds_byte(wr * 64 + fr, fq * 8), boff = lds_byte(wc * 32 + fr, fq * 8);
#define PG8_SA(b, h) (((b) * 2 + (h)) * HTB)
#define PG8_SB(b, h) ((4 + (b) * 2 + (h)) * HTB)
#define PG8_STAGE(bufoff, gbase, voff) do { _Pragma("unroll") for (int _i = 0; _i < 2; ++_i) \
        __builtin_amdgcn_global_load_lds((const unsigned*)((const char*)(gbase) + (voff)[_i]), (PG8_LAS unsigned*)(lds + (bufoff) + ldsw + _i * 8192), 16, 0, 0); } while (0)
#define PG8_LDA(dst, b, h) do { _Pragma("unroll") for (int m = 0; m < 4; ++m) _Pragma("unroll") for (int k = 0; k < 2; ++k) dst[m][k] = *(const PG8_LAS bf16x8*)(lds + PG8_SA(b, h) + aoff + m * 2048 + k * 1024); } while (0)
#define PG8_LDB(dst, b, h) do { _Pragma("unroll") for (int n = 0; n < 2; ++n) _Pragma("unroll") for (int k = 0; k < 2; ++k) dst[n][k] = *(const PG8_LAS bf16x8*)(lds + PG8_SB(b, h) + boff + n * 2048 + k * 1024); } while (0)
#define PG8_MMA(ai, bj, At, Bt) do { __builtin_amdgcn_s_setprio(1); _Pragma("unroll") for (int m = 0; m < 4; ++m) _Pragma("unroll") for (int n = 0; n < 2; ++n) _Pragma("unroll") for (int k = 0; k < 2; ++k) \
        acc[ai][bj][m][n] = __builtin_amdgcn_mfma_f32_16x16x32_bf16(Bt[n][k], At[m][k], acc[ai][bj][m][n], 0, 0, 0); __builtin_amdgcn_s_setprio(0); } while (0)
#define PG8_WAIT_V(n) asm volatile("s_waitcnt vmcnt(" #n ")" ::: "memory")
#define PG8_WAIT_L(n) asm volatile("s_waitcnt lgkmcnt(" #n ")" ::: "memory")
#define PG8_BAR __builtin_amdgcn_s_barrier()
#define PG8_SCHED __builtin_amdgcn_sched_barrier(0)
    Unit cur, nxt; int ui = 0;
    if (!S.next(0, cur)) return;
    f32x4 acc[2][2][4][2];
#pragma unroll
    for (int a = 0; a < 2; ++a)
#pragma unroll
        for (int b = 0; b < 2; ++b)
#pragma unroll
            for (int m = 0; m < 4; ++m)
#pragma unroll
                for (int n = 0; n < 2; ++n) acc[a][b][m][n] = (f32x4){0.f, 0.f, 0.f, 0.f};
    bf16x8 At[4][2], B0[2][2], B1[2][2];
    const char* cA = (const char*)g.A + (size_t)cur.pm * tstep; const char* cB = (const char*)g.Bt + (size_t)cur.pn * tstep;
    S.a_ready(cur);
    PG8_STAGE(PG8_SB(0, 0), cB, voffB); PG8_STAGE(PG8_SA(0, 0), cA, voffA); PG8_STAGE(PG8_SB(0, 1), cB + hstep, voffB); PG8_STAGE(PG8_SA(0, 1), cA + hstep, voffA);
    if (wr == 1) PG8_BAR;
    PG8_WAIT_V(4); PG8_BAR;
    PG8_STAGE(PG8_SB(1, 0), cB + kstep, voffB); PG8_STAGE(PG8_SA(1, 0), cA + kstep, voffA); PG8_STAGE(PG8_SB(1, 1), cB + hstep + kstep, voffB);
    PG8_WAIT_V(6); PG8_BAR;
    PG8_STAMP();
    for (;;) {
        const bool has_next = S.next(ui + 1, nxt);
        const char* nA = has_next ? (const char*)g.A + (size_t)nxt.pm * tstep : cA; const char* nB = has_next ? (const char*)g.Bt + (size_t)nxt.pn * tstep : cB;
        for (int t = 0; t < nt; t += 2) {
            const bool last = (t == nt - 2);
            const char* a1 = cA + (size_t)(t + 1) * kstep;
            const char* a2 = last ? nA : cA + (size_t)(t + 2) * kstep; const char* b2 = last ? nB : cB + (size_t)(t + 2) * kstep;
            const char* a3 = a2 + kstep; const char* b3 = b2 + kstep;
            if (last && has_next) S.a_ready(nxt);
            PG8_LDB(B0, 0, 0); PG8_SCHED; PG8_LDA(At, 0, 0); PG8_STAGE(PG8_SA(1, 1), a1 + hstep, voffA);
            PG8_WAIT_L(8); PG8_BAR; PG8_WAIT_L(0); PG8_MMA(0, 0, At, B0); PG8_BAR; PG8_SCHED;
            PG8_LDB(B1, 0, 1); PG8_STAGE(PG8_SB(0, 0), b2, voffB);
            PG8_BAR; PG8_WAIT_L(0); PG8_MMA(0, 1, At, B1); PG8_BAR;
            PG8_LDA(At, 0, 1); PG8_STAGE(PG8_SA(0, 0), a2, voffA);
            PG8_BAR; PG8_WAIT_L(0); PG8_MMA(1, 0, At, B0); PG8_BAR; PG8_SCHED;
            PG8_STAGE(PG8_SB(0, 1), b2 + hstep, voffB);
            PG8_WAIT_V(6); PG8_BAR; PG8_MMA(1, 1, At, B1); PG8_BAR;
            PG8_LDB(B0, 1, 0); PG8_SCHED; PG8_LDA(At, 1, 0); PG8_STAGE(PG8_SA(0, 1), a2 + hstep, voffA);
            PG8_WAIT_L(8); PG8_BAR; PG8_WAIT_L(0); PG8_MMA(0, 0, At, B0); PG8_BAR; PG8_SCHED;
            PG8_LDB(B1, 1, 1); PG8_STAGE(PG8_SB(1, 0), b3, voffB);
            PG8_BAR; PG8_WAIT_L(0); PG8_MMA(0, 1, At, B1); PG8_BAR;
            PG8_LDA(At, 1, 1); PG8_STAGE(PG8_SA(1, 0), a3, voffA);
            PG8_BAR; PG8_WAIT_L(0); PG8_MMA(1, 0, At, B0); PG8_BAR; PG8_SCHED;
            PG8_STAGE(PG8_SB(1, 1), b3 + hstep, voffB);
            PG8_WAIT_V(6); PG8_BAR; PG8_MMA(1, 1, At, B1); PG8_BAR;
        }
        PG8_STAMP();
        if constexpr (!Epi::AFTER_DRAIN) { E(acc, cur, wr, wc, fr, fq); S.done(cur); }
        PG8_STAMP();
        if (!has_next) break;
#pragma unroll
        for (int a = 0; a < 2; ++a)
#pragma unroll
            for (int b = 0; b < 2; ++b)
#pragma unroll
                for (int m = 0; m < 4; ++m)
#pragma unroll
                    for (int n = 0; n < 2; ++n) acc[a][b][m][n] = (f32x4){0.f, 0.f, 0.f, 0.f};
        cur = nxt; cA = nA; cB = nB; ++ui;
    }
    PG8_WAIT_V(0);
    if (wr == 0) PG8_BAR;
    PG8_BAR;
    if constexpr (Epi::AFTER_DRAIN) { E.fused(acc, cur, wr, wc, fr, fq, lds, wid, lane); S.done(cur); }
    PG8_STAMP();
    if (STAMP && wid == 0) { stamps[lane] = lane < nts ? (((unsigned long long)(unsigned)ts_hi << 32) | (unsigned)ts_lo) : 0ull;
        if (lane == 62) stamps[62] = rt_entry; if (lane == 63) stamps[63] = (unsigned long long)wall_clock64(); }
#undef PG8_STAMP
#undef PG8_SA
#undef PG8_SB
#undef PG8_STAGE
#undef PG8_LDA
#undef PG8_LDB
#undef PG8_MMA
#undef PG8_WAIT_V
#undef PG8_WAIT_L
#undef PG8_BAR
#undef PG8_SCHED
}
}

using pg8::bf16_t; using pg8::bf16x8; using pg8::f32x4; using pg8::u32x4; using pg8::f32x2;
typedef unsigned u32x2 __attribute__((ext_vector_type(2)));

constexpr int MP = 65536, MS = 512, MT = MP + MS, DM = 1024;
constexpr int NAB = 2560, NCD = 3072, NCDF = 3080, FH = 2816;
constexpr int NPH = 17;
#ifndef PHM
#define PHM 0xFFFFF
#endif
constexpr int LDS_BYTES = 131072;

constexpr size_t O_Y_P = 0;
constexpr size_t O_Y_S = O_Y_P + (size_t)MP * DM;
constexpr size_t O_CONVA_P = O_Y_S + (size_t)MS * DM;
constexpr size_t O_CONVA_S = O_CONVA_P + 16 * 2 * 512;
constexpr size_t O_VB_S = O_CONVA_S + 8 * 2 * 512;
constexpr size_t O_KC_P = O_VB_S + 8 * 64 * 512;
constexpr size_t O_VC_P = O_KC_P + (size_t)16 * 512 * 512;
constexpr size_t O_KC_S = O_VC_P + (size_t)16 * 512 * 512;
constexpr size_t O_VC_S = O_KC_S + 8 * 64 * 512;
constexpr size_t O_CONVD_P = O_VC_S + 8 * 64 * 512;
constexpr size_t O_CONVD_S = O_CONVD_P + 16 * 3 * 1024;
constexpr size_t O_SSM_P = O_CONVD_S + 8 * 3 * 1024;
constexpr size_t O_SSM_S = O_SSM_P + (size_t)16 * 65536;
constexpr size_t O_END = O_SSM_S + (size_t)8 * 65536;

constexpr size_t WS_WT_INAB = 0;
constexpr size_t WS_WT_OUTAB = WS_WT_INAB + (size_t)NAB * DM * 2;
constexpr size_t WS_WT_INCD = WS_WT_OUTAB + (size_t)DM * DM * 2;
constexpr size_t WS_WT_OUTCD = WS_WT_INCD + (size_t)NCD * DM * 2;
constexpr size_t WS_WT_GU = WS_WT_OUTCD + (size_t)DM * DM * 2;
constexpr size_t WS_WT_DN = WS_WT_GU + (size_t)2 * 2 * FH * DM * 2;
constexpr size_t WS_XN = WS_WT_DN + (size_t)2 * DM * FH * 2;
constexpr size_t WS_PROJ = WS_XN + (size_t)MT * DM * 2;
constexpr size_t WS_MIX = WS_PROJ + (size_t)MT * NCD * 2;
constexpr size_t WS_SBUF = WS_MIX + (size_t)MT * DM * 2;
constexpr size_t WS_DT = WS_SBUF + (size_t)1032 * 65536 * 4;
constexpr size_t WS_DEC = WS_DT + (size_t)MT * 8 * 4;
constexpr size_t WS_CK = WS_DEC + (size_t)1032 * 8 * 4 + 128;
constexpr size_t WS_CV = WS_CK + (size_t)8 * 512 * 512 * 2;
constexpr size_t WS_END = WS_CV + (size_t)8 * 512 * 512 * 2;

struct Params {
    const float *x_prompt, *x_sample, *cache_k, *cache_v, *state_conv_a, *state_conv_d, *state_ssm_d;
    const float *norm_mix, *norm_ffn, *norm_final, *w_in_ab, *conv_w_a, *ln_g_b, *ln_b_b, *w_s_b, *b_s_b, *w_out_ab, *w_in_cd, *rel_bias_c, *conv_w_d, *conv_b_d,
        *dt_bias_d, *a_log_d, *d_skip_d, *norm_g_d, *w_out_cd, *w_gate, *w_up, *w_down;
    float* out; unsigned char* ws;
    int ph_lo, ph_hi;
};

__device__ __forceinline__ int ltid() { int t = threadIdx.x; asm volatile("" : "+v"(t)); return t; }
__device__ __forceinline__ unsigned pk2(float lo, float hi) { unsigned r; asm("v_cvt_pk_bf16_f32 %0, %1, %2" : "=v"(r) : "v"(lo), "v"(hi)); return r; }
__device__ __forceinline__ unsigned short f2bf(float f) { return (unsigned short)(pk2(f, 0.f) & 0xffffu); }
__device__ __forceinline__ float bflo(unsigned w) { return __uint_as_float(w << 16); }
__device__ __forceinline__ float bfhi(unsigned w) { return __uint_as_float(w & 0xffff0000u); }
#define UNPACK8(v, f) do { f[0] = bflo(v[0]); f[1] = bfhi(v[0]); f[2] = bflo(v[1]); f[3] = bfhi(v[1]); f[4] = bflo(v[2]); f[5] = bfhi(v[2]); f[6] = bflo(v[3]); f[7] = bfhi(v[3]); } while (0)
#define PACK8(f) ((u32x4){pk2(f[0], f[1]), pk2(f[2], f[3]), pk2(f[4], f[5]), pk2(f[6], f[7])})
__device__ __forceinline__ float wave_sum(float v) {
#pragma unroll
    for (int o = 32; o; o >>= 1) v += __shfl_xor(v, o);
    return v;
}
__device__ __forceinline__ float silu_f(float x) { return x * __builtin_amdgcn_rcpf(1.f + __expf(-x)); }
__device__ __forceinline__ bf16x8 as_bf16x8(u32x4 v) { union { u32x4 u; bf16x8 b; } c; c.u = v; return c.b; }
#define MFMA16(a, b, c) __builtin_amdgcn_mfma_f32_16x16x32_bf16((a), (b), (c), 0, 0, 0)

struct EpiProjAB {
    static constexpr bool PERM = true, AFTER_DRAIN = false;
    bf16_t* O;
    __device__ __forceinline__ void operator()(const f32x4 (&acc)[2][2][4][2], const pg8::Unit& u, int wr, int wc, int fr, int fq) const {
        const int row0 = u.pm * 256 + wr * 64 + fr, col0 = u.pn * 256 + wc * 32 + 8 * fq;
        const bool act = u.pn >= 6;
#pragma unroll
        for (int ai = 0; ai < 2; ++ai)
#pragma unroll
            for (int m = 0; m < 4; ++m) { bf16_t* rowp = O + (size_t)(row0 + ai * 128 + m * 16) * NAB + col0;
#pragma unroll
                for (int bj = 0; bj < 2; ++bj) { f32x4 v0 = acc[ai][bj][m][0], v1 = acc[ai][bj][m][1];
                    if (act) { f32x2 a = pg8::gelu_pk((f32x2){v0[0], v0[1]}), b = pg8::gelu_pk((f32x2){v0[2], v0[3]}), c = pg8::gelu_pk((f32x2){v1[0], v1[1]}), d = pg8::gelu_pk((f32x2){v1[2], v1[3]});
                        v0 = (f32x4){a.x, a.y, b.x, b.y}; v1 = (f32x4){c.x, c.y, d.x, d.y}; }
                    *(u32x4*)(rowp + bj * 128) = (u32x4){pk2(v0[0], v0[1]), pk2(v0[2], v0[3]), pk2(v1[0], v1[1]), pk2(v1[2], v1[3])}; } }
    }
};
struct EpiRes {
    static constexpr bool PERM = false, AFTER_DRAIN = false;
    float* H; const float* R0; const float* R1;
    __device__ __forceinline__ void operator()(const f32x4 (&acc)[2][2][4][2], const pg8::Unit& u, int wr, int wc, int fr, int fq) const {
        const int row0 = u.pm * 256 + wr * 64 + fr, col0 = u.pn * 256 + wc * 32 + 4 * fq;
        const float* rb = (u.pm < 256) ? R0 + (size_t)row0 * DM + col0 : R1 + (size_t)(row0 - MP) * DM + col0;
        float* hb = H + (size_t)row0 * DM + col0;
#pragma unroll
        for (int ai = 0; ai < 2; ++ai)
#pragma unroll
            for (int m = 0; m < 4; ++m) { const size_t ro = (size_t)(ai * 128 + m * 16) * DM;
#pragma unroll
                for (int bj = 0; bj < 2; ++bj)
#pragma unroll
                    for (int n = 0; n < 2; ++n) { const f32x4 r = *(const f32x4*)(rb + ro + bj * 128 + n * 16); *(f32x4*)(hb + ro + bj * 128 + n * 16) = r + acc[ai][bj][m][n]; } }
    }
};
struct EpiSwiglu {
    static constexpr bool PERM = true, AFTER_DRAIN = false;
    bf16_t* O;
    __device__ __forceinline__ void operator()(const f32x4 (&acc)[2][2][4][2], const pg8::Unit& u, int wr, int wc, int fr, int fq) const {
        const int row0 = u.pm * 256 + wr * 64 + fr, col0 = u.pn * 128 + wc * 32 + 8 * fq;
#pragma unroll
        for (int ai = 0; ai < 2; ++ai)
#pragma unroll
            for (int m = 0; m < 4; ++m) { bf16_t* rowp = O + (size_t)(row0 + ai * 128 + m * 16) * FH + col0;
                const f32x4 g0 = acc[ai][0][m][0], g1 = acc[ai][0][m][1], u0 = acc[ai][1][m][0], u1 = acc[ai][1][m][1];
                float h[8];
#pragma unroll
                for (int j = 0; j < 4; ++j) { h[j] = silu_f(g0[j]) * u0[j]; h[4 + j] = silu_f(g1[j]) * u1[j]; }
                *(u32x4*)rowp = PACK8(h); }
    }
};
struct EpiProjCD {
    static constexpr bool PERM = true, AFTER_DRAIN = false;
    bf16_t* O; float* out;
    __device__ __forceinline__ void operator()(const f32x4 (&acc)[2][2][4][2], const pg8::Unit& u, int wr, int wc, int fr, int fq) const {
        const int row0 = u.pm * 256 + wr * 64 + fr, col0 = u.pn * 256 + wc * 32 + 8 * fq;
        const bool smp = u.pm >= 256; const int pmb = u.pm & 15;
        const bool kv = (u.pn >= 2 && u.pn < 6) && (smp || pmb >= 14), cvd = (u.pn >= 8) && (smp || pmb == 15);
#pragma unroll
        for (int ai = 0; ai < 2; ++ai)
#pragma unroll
            for (int m = 0; m < 4; ++m) { const int r = row0 + ai * 128 + m * 16; bf16_t* rowp = O + (size_t)r * NCD + col0;
#pragma unroll
                for (int bj = 0; bj < 2; ++bj) { const f32x4 v0 = acc[ai][bj][m][0], v1 = acc[ai][bj][m][1];
                    *(u32x4*)(rowp + bj * 128) = (u32x4){pk2(v0[0], v0[1]), pk2(v0[2], v0[3]), pk2(v1[0], v1[1]), pk2(v1[2], v1[3])};
                    if (kv) { const int c = col0 + bj * 128; const bool isv = c >= 1024; const int cc = c - (isv ? 1024 : 512); float* o;
                        if (smp) o = out + (isv ? O_VC_S : O_KC_S) + (size_t)(r - MP) * 512 + cc;
                        else { const int b = r >> 12, t = r & 4095; o = out + (isv ? O_VC_P : O_KC_P) + ((size_t)b * 512 + (t - 3584)) * 512 + cc; }
                        *(f32x4*)o = v0; *(f32x4*)(o + 4) = v1; }
                    if (cvd) { const int cc = col0 + bj * 128 - 2048;
                        if (smp) { const int sb = (r - MP) >> 6, t = (r - MP) & 63; if (t >= 61) { float* o = out + O_CONVD_S + ((size_t)sb * 3 + (t - 61)) * 1024 + cc; *(f32x4*)o = v0; *(f32x4*)(o + 4) = v1; } }
                        else { const int b = r >> 12, t = r & 4095; if (t >= 4093) { float* o = out + O_CONVD_P + ((size_t)b * 3 + (t - 4093)) * 1024 + cc; *(f32x4*)o = v0; *(f32x4*)(o + 4) = v1; } } } } }
    }
};

template <class Epi> __device__ __forceinline__ void run_gemm(unsigned char* lds, const bf16_t* A, const bf16_t* Bt, int N, int K, const Epi& E) {
    pg8::Gemm g{A, Bt, MT, N, K}; pg8::StaticOrder S; S.init(MT, N, (int)gridDim.x, (int)blockIdx.x);
    pg8::gemm_phase<Epi, pg8::StaticOrder, false>((PG8_LAS unsigned char*)lds, g, S, E, nullptr);
}

__device__ __forceinline__ void wt_tile(const float* __restrict__ src, int ld, int col0, int k0, bf16_t* __restrict__ dst, int drow0, int Kd, float* tl) {
    const int tid = ltid();
#pragma unroll
    for (int i = 0; i < 2; ++i) { const int k = (tid >> 4) + 32 * i, n4 = (tid & 15) * 4;
        const float4 v = *(const float4*)(src + (size_t)(k0 + k) * ld + col0 + n4);
        tl[k * 65 + n4] = v.x; tl[k * 65 + n4 + 1] = v.y; tl[k * 65 + n4 + 2] = v.z; tl[k * 65 + n4 + 3] = v.w; }
    __syncthreads();
    { const int n = tid >> 3, k8 = (tid & 7) * 8; float f[8];
#pragma unroll
      for (int i = 0; i < 8; ++i) f[i] = tl[(k8 + i) * 65 + n];
      *(u32x4*)(dst + (size_t)(drow0 + n) * Kd + k0 + k8) = PACK8(f); }
    __syncthreads();
}
__device__ __forceinline__ void phase_prep(const Params& p, unsigned char* lds) {
    float* tl = (float*)lds;
    for (int t = blockIdx.x; t < 6144; t += gridDim.x) {
        int q = t;
        if (q < 640) { const int nt = q >> 4, kt = q & 15; wt_tile(p.w_in_ab, NAB, nt * 64, kt * 64, (bf16_t*)(p.ws + WS_WT_INAB), nt * 64, DM, tl); continue; } q -= 640;
        if (q < 256) { const int nt = q >> 4, kt = q & 15; wt_tile(p.w_out_ab, DM, nt * 64, kt * 64, (bf16_t*)(p.ws + WS_WT_OUTAB), nt * 64, DM, tl); continue; } q -= 256;
        if (q < 768) { const int nt = q >> 4, kt = q & 15; wt_tile(p.w_in_cd, NCDF, nt * 64, kt * 64, (bf16_t*)(p.ws + WS_WT_INCD), nt * 64, DM, tl); continue; } q -= 768;
        if (q < 256) { const int nt = q >> 4, kt = q & 15; wt_tile(p.w_out_cd, DM, nt * 64, kt * 64, (bf16_t*)(p.ws + WS_WT_OUTCD), nt * 64, DM, tl); continue; } q -= 256;
        if (q < 2816) { const int layer = q / 1408; q -= layer * 1408; const int nt = q >> 4, kt = q & 15, pn = nt >> 2, bj = (nt & 3) >> 1, i0 = (nt & 1) * 64;
            wt_tile((bj ? p.w_up : p.w_gate) + (size_t)layer * DM * FH, FH, 128 * pn + i0, kt * 64, (bf16_t*)(p.ws + WS_WT_GU) + (size_t)layer * 2 * FH * DM, nt * 64, DM, tl); continue; } q -= 2816;
        { const int layer = q / 704; q -= layer * 704; const int nt = q / 44, kt = q - nt * 44;
            wt_tile(p.w_down + (size_t)layer * FH * DM, DM, nt * 64, kt * 64, (bf16_t*)(p.ws + WS_WT_DN) + (size_t)layer * DM * FH, nt * 64, FH, tl); }
    }
    { const size_t n8 = (size_t)8 * 512 * 512 / 8; bf16_t* CK = (bf16_t*)(p.ws + WS_CK); bf16_t* CV = (bf16_t*)(p.ws + WS_CV);
      for (size_t i = (size_t)blockIdx.x * 512 + ltid(); i < 2 * n8; i += (size_t)gridDim.x * 512) {
          const bool isv = i >= n8; const size_t e = (isv ? i - n8 : i) * 8; const float* s = (isv ? p.cache_v : p.cache_k) + e;
          const float4 a = *(const float4*)s, b = *(const float4*)(s + 4);
          *(u32x4*)((isv ? CV : CK) + e) = (u32x4){pk2(a.x, a.y), pk2(a.z, a.w), pk2(b.x, b.y), pk2(b.z, b.w)}; } }
}

template <bool WITH_DT>
__device__ __forceinline__ void phase_rmsnorm(const Params& p, unsigned char* lds, const float* src0, const float* src1, const float* gw) {
    const int tid = ltid(), wid = tid >> 6, lane = tid & 63;
    bf16_t* XN = (bf16_t*)(p.ws + WS_XN); float* DT = (float*)(p.ws + WS_DT); float* wl = (float*)lds;
    if (WITH_DT) {
        for (int idx = tid; idx < 8192; idx += 512) { const int q = idx & 3, ln = (idx >> 2) & 63, half = (idx >> 8) & 1, ij = idx >> 9, k = (ij >> 2) * 256 + ln * 4 + (ij & 3);
            wl[idx] = p.w_in_cd[(size_t)k * NCDF + NCD + half * 4 + q]; }
        __syncthreads();
    }
    float4 gv[4];
#pragma unroll
    for (int i = 0; i < 4; ++i) gv[i] = *(const float4*)(gw + i * 256 + lane * 4);
    for (int row = blockIdx.x * 8 + wid; row < MT; row += gridDim.x * 8) {
        const float* s = row < MP ? src0 + (size_t)row * DM : src1 + (size_t)(row - MP) * DM;
        float4 v[4]; float ss = 0.f;
#pragma unroll
        for (int i = 0; i < 4; ++i) { v[i] = *(const float4*)(s + i * 256 + lane * 4); ss += v[i].x * v[i].x + v[i].y * v[i].y + v[i].z * v[i].z + v[i].w * v[i].w; }
        ss = wave_sum(ss); const float rstd = rsqrtf(ss * (1.f / 1024.f) + 1e-5f);
        float d[8];
#pragma unroll
        for (int h = 0; h < 8; ++h) d[h] = 0.f;
#pragma unroll
        for (int i = 0; i < 4; ++i) { const float y0 = v[i].x * rstd * gv[i].x, y1 = v[i].y * rstd * gv[i].y, y2 = v[i].z * rstd * gv[i].z, y3 = v[i].w * rstd * gv[i].w;
            *(u32x2*)(XN + (size_t)row * DM + i * 256 + lane * 4) = (u32x2){pk2(y0, y1), pk2(y2, y3)};
            if (WITH_DT) { const float yy[4] = {y0, y1, y2, y3};
#pragma unroll
                for (int j = 0; j < 4; ++j) { const int ij = i * 4 + j; const float4 wa = *(const float4*)(wl + ((ij * 2 + 0) * 64 + lane) * 4), wb = *(const float4*)(wl + ((ij * 2 + 1) * 64 + lane) * 4);
                    d[0] += yy[j] * wa.x; d[1] += yy[j] * wa.y; d[2] += yy[j] * wa.z; d[3] += yy[j] * wa.w; d[4] += yy[j] * wb.x; d[5] += yy[j] * wb.y; d[6] += yy[j] * wb.z; d[7] += yy[j] * wb.w; } } }
        if (WITH_DT) {
            float e4[4], e2[2], e1; bool up = (lane & 32) != 0;
#pragma unroll
            for (int i = 0; i < 4; ++i) { const float snd = up ? d[i] : d[i + 4], kp = up ? d[i + 4] : d[i]; e4[i] = kp + __shfl_xor(snd, 32); }
            up = (lane & 16) != 0;
#pragma unroll
            for (int i = 0; i < 2; ++i) { const float snd = up ? e4[i] : e4[i + 2], kp = up ? e4[i + 2] : e4[i]; e2[i] = kp + __shfl_xor(snd, 16); }
            up = (lane & 8) != 0;
            { const float snd = up ? e2[0] : e2[1], kp = up ? e2[1] : e2[0]; e1 = kp + __shfl_xor(snd, 8); }
            e1 += __shfl_xor(e1, 4); e1 += __shfl_xor(e1, 2); e1 += __shfl_xor(e1, 1);
            if ((lane & 7) == 0) { const int h = ((lane >> 5) & 1) * 4 + ((lane >> 4) & 1) * 2 + ((lane >> 3) & 1); DT[(size_t)row * 8 + h] = e1; }
        }
    }
}
__device__ __forceinline__ void phase_final_norm(const Params& p) {
    const int tid = ltid(), wid = tid >> 6, lane = tid & 63;
    float4 gv[4];
#pragma unroll
    for (int i = 0; i < 4; ++i) gv[i] = *(const float4*)(p.norm_final + i * 256 + lane * 4);
    for (int row = blockIdx.x * 8 + wid; row < MT; row += gridDim.x * 8) {
        float* s = p.out + (size_t)row * DM; float4 v[4]; float ss = 0.f;
#pragma unroll
        for (int i = 0; i < 4; ++i) { v[i] = *(const float4*)(s + i * 256 + lane * 4); ss += v[i].x * v[i].x + v[i].y * v[i].y + v[i].z * v[i].z + v[i].w * v[i].w; }
        ss = wave_sum(ss); const float rstd = rsqrtf(ss * (1.f / 1024.f) + 1e-5f);
#pragma unroll
        for (int i = 0; i < 4; ++i) *(float4*)(s + i * 256 + lane * 4) = make_float4(v[i].x * rstd * gv[i].x, v[i].y * rstd * gv[i].y, v[i].z * rstd * gv[i].z, v[i].w * rstd * gv[i].w);
    }
}

__device__ __forceinline__ void phase_mixer_ab(const Params& p, unsigned char* lds) {
    const int tid = ltid(), wid = tid >> 6, lane = tid & 63, fr = lane & 15, G = lane >> 4;
    const bf16_t* PROJ = (const bf16_t*)(p.ws + WS_PROJ); bf16_t* MIX = (bf16_t*)(p.ws + WS_MIX);
    float* mu = (float*)lds; float* rs = mu + 128;
    bf16_t* VT = (bf16_t*)(lds + 1024); bf16_t* WSm = (bf16_t*)(lds + 1024 + 128 * 136 * 2);
    for (int u = blockIdx.x; u < 520; u += gridDim.x) {
        const bool smp = u >= 512; const int b = smp ? u - 512 : (u >> 5), blk = smp ? 0 : (u & 31);
        const int L = smp ? 64 : 128, rpw = L >> 3, t0 = wid * rpw;
        const size_t row0 = smp ? (size_t)MP + (size_t)b * 64 : (size_t)b * 4096 + (size_t)blk * 128;
        { const int c8 = lane * 8; float w0[8], w1[8], w2[8], um2[8], um1[8];
          { const float4 a0 = *(const float4*)(p.conv_w_a + c8), a1 = *(const float4*)(p.conv_w_a + c8 + 4), b0 = *(const float4*)(p.conv_w_a + 512 + c8), b1 = *(const float4*)(p.conv_w_a + 512 + c8 + 4),
                c0 = *(const float4*)(p.conv_w_a + 1024 + c8), c1 = *(const float4*)(p.conv_w_a + 1024 + c8 + 4);
            w0[0] = a0.x; w0[1] = a0.y; w0[2] = a0.z; w0[3] = a0.w; w0[4] = a1.x; w0[5] = a1.y; w0[6] = a1.z; w0[7] = a1.w;
            w1[0] = b0.x; w1[1] = b0.y; w1[2] = b0.z; w1[3] = b0.w; w1[4] = b1.x; w1[5] = b1.y; w1[6] = b1.z; w1[7] = b1.w;
            w2[0] = c0.x; w2[1] = c0.y; w2[2] = c0.z; w2[3] = c0.w; w2[4] = c1.x; w2[5] = c1.y; w2[6] = c1.z; w2[7] = c1.w; }
          const int tg = blk * 128 + t0;
          if (tg > 0) {
              const bf16_t* p2 = PROJ + (row0 + t0 - 2) * NAB; const bf16_t* p1 = PROJ + (row0 + t0 - 1) * NAB;
              const u32x4 xa2 = *(const u32x4*)(p2 + c8), gc2 = *(const u32x4*)(p2 + 1024 + c8), xa1 = *(const u32x4*)(p1 + c8), gc1 = *(const u32x4*)(p1 + 1024 + c8);
              float fa[8], fb[8]; UNPACK8(xa2, fa); UNPACK8(gc2, fb);
#pragma unroll
              for (int k = 0; k < 8; ++k) um2[k] = fa[k] * fb[k];
              UNPACK8(xa1, fa); UNPACK8(gc1, fb);
#pragma unroll
              for (int k = 0; k < 8; ++k) um1[k] = fa[k] * fb[k];
          } else if (smp) {
              const float* h0 = p.state_conv_a + ((size_t)b * 2) * 512 + c8; const float4 a0 = *(const float4*)h0, a1 = *(const float4*)(h0 + 4), b0 = *(const float4*)(h0 + 512), b1 = *(const float4*)(h0 + 516);
              um2[0] = a0.x; um2[1] = a0.y; um2[2] = a0.z; um2[3] = a0.w; um2[4] = a1.x; um2[5] = a1.y; um2[6] = a1.z; um2[7] = a1.w;
              um1[0] = b0.x; um1[1] = b0.y; um1[2] = b0.z; um1[3] = b0.w; um1[4] = b1.x; um1[5] = b1.y; um1[6] = b1.z; um1[7] = b1.w;
          } else {
#pragma unroll
              for (int k = 0; k < 8; ++k) { um2[k] = 0.f; um1[k] = 0.f; }
          }
          for (int i = 0; i < rpw; ++i) { const int t = t0 + i; const size_t r = row0 + t; const bf16_t* pr = PROJ + r * NAB;
              const u32x4 xa = *(const u32x4*)(pr + c8), gb = *(const u32x4*)(pr + 512 + c8), gc = *(const u32x4*)(pr + 1024 + c8);
              float fa[8], fb[8], fc[8], U[8], y[8]; UNPACK8(xa, fa); UNPACK8(gb, fb); UNPACK8(gc, fc);
#pragma unroll
              for (int k = 0; k < 8; ++k) { U[k] = fc[k] * fa[k]; y[k] = fb[k] * (w0[k] * um2[k] + w1[k] * um1[k] + w2[k] * U[k]); }
              *(u32x4*)(MIX + r * DM + c8) = PACK8(y);
              if (t >= L - 2 && (smp || blk == 31)) { float* o = p.out + (smp ? O_CONVA_S : O_CONVA_P) + ((size_t)b * 2 + (t - (L - 2))) * 512 + c8;
                  *(float4*)o = make_float4(U[0], U[1], U[2], U[3]); *(float4*)(o + 4) = make_float4(U[4], U[5], U[6], U[7]); }
#pragma unroll
              for (int k = 0; k < 8; ++k) { um2[k] = um1[k]; um1[k] = U[k]; } }
        }
        for (int i = 0; i < rpw; ++i) { const int t = t0 + i; const size_t r = row0 + t;
            const u32x4 vv = *(const u32x4*)(PROJ + r * NAB + 2048 + lane * 8); float f[8]; UNPACK8(vv, f);
            float s = 0.f;
#pragma unroll
            for (int k = 0; k < 8; ++k) s += f[k];
            s = wave_sum(s); const float mean = s * (1.f / 512.f); float q = 0.f;
#pragma unroll
            for (int k = 0; k < 8; ++k) { const float dd = f[k] - mean; q += dd * dd; }
            q = wave_sum(q); const float rstd = rsqrtf(q * (1.f / 512.f) + 1e-5f);
            if (lane == 0) { mu[t] = mean; rs[t] = rstd; }
            if (smp) { const float* gp = p.ln_g_b + lane * 8; const float* bp = p.ln_b_b + lane * 8; float o8[8];
#pragma unroll
                for (int k = 0; k < 8; ++k) o8[k] = (f[k] - mean) * rstd * gp[k] + bp[k];
                float* o = p.out + O_VB_S + (r - MP) * 512 + lane * 8; *(float4*)o = make_float4(o8[0], o8[1], o8[2], o8[3]); *(float4*)(o + 4) = make_float4(o8[4], o8[5], o8[6], o8[7]); } }
        __syncthreads();
        for (int g = 0; g < 4; ++g) {
#pragma unroll
            for (int i = 0; i < 4; ++i) { const int id = tid + 512 * i, t = id >> 4, c8 = (id & 15) * 8;
                if (t < L) { const u32x4 vv = *(const u32x4*)(PROJ + (row0 + t) * NAB + 2048 + g * 128 + c8); float f[8]; UNPACK8(vv, f);
                    const float mean = mu[t], rstd = rs[t]; const float* gp = p.ln_g_b + g * 128 + c8; const float* bp = p.ln_b_b + g * 128 + c8;
#pragma unroll
                    for (int k = 0; k < 8; ++k) VT[(c8 + k) * 136 + t] = f2bf((f[k] - mean) * rstd * gp[k] + bp[k]); } }
#pragma unroll
            for (int i = 0; i < 4; ++i) { const int id = tid + 512 * i, t = id >> 4, s8 = (id & 15) * 8;
                if (t < L && s8 < L) { const float* wp = p.w_s_b + ((size_t)g * 128 + t) * 128 + s8; const float4 a = *(const float4*)wp, bb = *(const float4*)(wp + 4);
                    float f[8] = {a.x, a.y, a.z, a.w, bb.x, bb.y, bb.z, bb.w};
#pragma unroll
                    for (int k = 0; k < 8; ++k) f[k] = (s8 + k <= t) ? f[k] : 0.f;
                    *(u32x4*)(WSm + t * 136 + s8) = PACK8(f); } }
            __syncthreads();
            if (wid < (L >> 4)) {
                f32x4 acc[8];
#pragma unroll
                for (int ct = 0; ct < 8; ++ct) acc[ct] = (f32x4){0.f, 0.f, 0.f, 0.f};
                const int nks = (16 * (wid + 1) + 31) >> 5;
                for (int ks = 0; ks < nks; ++ks) { const bf16x8 bw = *(const bf16x8*)(WSm + (16 * wid + fr) * 136 + 32 * ks + 8 * G);
#pragma unroll
                    for (int ct = 0; ct < 8; ++ct) { const bf16x8 av = *(const bf16x8*)(VT + (16 * ct + fr) * 136 + 32 * ks + 8 * G); acc[ct] = MFMA16(av, bw, acc[ct]); } }
                const int t = 16 * wid + fr; const float bs = p.b_s_b[g * 128 + t]; const size_t r = row0 + t;
#pragma unroll
                for (int ct = 0; ct < 8; ++ct) { const int c = 16 * ct + 4 * G; const u32x2 uu = *(const u32x2*)(PROJ + r * NAB + 1536 + g * 128 + c);
                    const float y0 = bflo(uu[0]) * (acc[ct][0] + bs), y1 = bfhi(uu[0]) * (acc[ct][1] + bs), y2 = bflo(uu[1]) * (acc[ct][2] + bs), y3 = bfhi(uu[1]) * (acc[ct][3] + bs);
                    *(u32x2*)(MIX + r * DM + 512 + g * 128 + c) = (u32x2){pk2(y0, y1), pk2(y2, y3)}; }
            }
            __syncthreads();
        }
    }
}

constexpr int N_ATT = 4096 + 64;
__device__ __forceinline__ void att_unit(const Params& p, unsigned char* lds, int v) {
    const int tid = ltid(), wid = tid >> 6, lane = tid & 63, fr = lane & 15, G = lane >> 4;
    const bf16_t* PROJ = (const bf16_t*)(p.ws + WS_PROJ); bf16_t* MIX = (bf16_t*)(p.ws + WS_MIX);
    const bf16_t* CK = (const bf16_t*)(p.ws + WS_CK); const bf16_t* CV = (const bf16_t*)(p.ws + WS_CV);
    float* tab = (float*)lds; bf16_t* KSB = (bf16_t*)(lds + 1040);
    const bool smp = v >= 4096; int b, h, c0, jlo, jhi;
    if (!smp) { b = v >> 8; h = (v >> 5) & 7; c0 = 2 * (v & 31); jlo = c0 - 8 > 0 ? c0 - 8 : 0; jhi = c0 + 1; }
    else { const int sv = v - 4096; b = sv >> 3; h = sv & 7; c0 = 8; jlo = 0; jhi = 8; }
    const int cq = c0 + (wid >> 2), qt = wid & 3; const bool wact = !smp || wid < 4;
    const size_t qrow = smp ? (size_t)MP + (size_t)b * 64 + qt * 16 + fr : (size_t)b * 4096 + (size_t)cq * 64 + qt * 16 + fr;
    for (int i = tid; i < 257; i += 512) tab[i] = p.rel_bias_c[h * 257 + i];
    bf16x8 qf[2];
#pragma unroll
    for (int ks = 0; ks < 2; ++ks) qf[ks] = wact ? *(const bf16x8*)(PROJ + qrow * NCD + h * 64 + 32 * ks + 8 * G) : (bf16x8){0, 0, 0, 0, 0, 0, 0, 0};
    const int skey = tid >> 3, sd8 = (tid & 7) * 8;
    u32x4 kr, vr;
#define ATT_LOAD(j) do { if (!smp || (j) == 8) { const size_t rr = (smp ? (size_t)MP + (size_t)b * 64 : (size_t)b * 4096 + (size_t)(j) * 64) + skey; const bf16_t* sp = PROJ + rr * NCD + 512 + h * 64 + sd8; \
        kr = *(const u32x4*)sp; vr = *(const u32x4*)(sp + 512); } else { const size_t off = ((size_t)b * 512 + (size_t)(j) * 64 + skey) * 512 + h * 64 + sd8; kr = *(const u32x4*)(CK + off); vr = *(const u32x4*)(CV + off); } } while (0)
    ATT_LOAD(jlo);
    float m = -1e30f, lsum = 0.f; f32x4 O[4];
#pragma unroll
    for (int dt = 0; dt < 4; ++dt) O[dt] = (f32x4){0.f, 0.f, 0.f, 0.f};
    for (int j = jlo; j <= jhi; ++j) {
        bf16_t* KS = KSB + ((j - jlo) & 1) * 9216; bf16_t* VTt = KS + 4608;
        *(u32x4*)(KS + skey * 72 + sd8) = kr;
#pragma unroll
        for (int k = 0; k < 8; ++k) VTt[(sd8 + k) * 72 + skey] = (unsigned short)((k & 1) ? (vr[k >> 1] >> 16) : (vr[k >> 1] & 0xffffu));
        __syncthreads();
        if (j < jhi) ATT_LOAD(j + 1);
        if (wact && j >= cq - 8 && j <= cq) {
            f32x4 s[4];
#pragma unroll
            for (int kt = 0; kt < 4; ++kt) { s[kt] = (f32x4){0.f, 0.f, 0.f, 0.f};
#pragma unroll
                for (int ks = 0; ks < 2; ++ks) { const bf16x8 a = *(const bf16x8*)(KS + (16 * kt + fr) * 72 + 32 * ks + 8 * G); s[kt] = MFMA16(a, qf[ks], s[kt]); } }
            const int rel0 = (cq * 64 + qt * 16 + fr) - (j * 64 + 4 * G);
            float mx = -1e30f;
#pragma unroll
            for (int kt = 0; kt < 4; ++kt)
#pragma unroll
                for (int r = 0; r < 4; ++r) { int rel = rel0 - 16 * kt - r; rel = rel < -128 ? -128 : (rel > 128 ? 128 : rel); const float sv = s[kt][r] * 0.125f + tab[rel + 128]; s[kt][r] = sv; mx = fmaxf(mx, sv); }
            mx = fmaxf(mx, __shfl_xor(mx, 16)); mx = fmaxf(mx, __shfl_xor(mx, 32));
            const float mnew = fmaxf(m, mx), alpha = __expf(m - mnew); m = mnew;
            float ps = 0.f;
#pragma unroll
            for (int kt = 0; kt < 4; ++kt)
#pragma unroll
                for (int r = 0; r < 4; ++r) { const float e = __expf(s[kt][r] - mnew); s[kt][r] = e; ps += e; }
            lsum = lsum * alpha + ps;
#pragma unroll
            for (int dt = 0; dt < 4; ++dt) O[dt] = O[dt] * alpha;
#pragma unroll
            for (int kk = 0; kk < 2; ++kk) {
                const bf16x8 pb = as_bf16x8((u32x4){pk2(s[2 * kk][0], s[2 * kk][1]), pk2(s[2 * kk][2], s[2 * kk][3]), pk2(s[2 * kk + 1][0], s[2 * kk + 1][1]), pk2(s[2 * kk + 1][2], s[2 * kk + 1][3])});
#pragma unroll
                for (int dt = 0; dt < 4; ++dt) { const bf16_t* vp = VTt + (16 * dt + fr) * 72 + 32 * kk + 4 * G; const u32x2 v0 = *(const u32x2*)vp, v1 = *(const u32x2*)(vp + 16);
                    O[dt] = MFMA16(as_bf16x8((u32x4){v0[0], v0[1], v1[0], v1[1]}), pb, O[dt]); }
            }
        }
    }
#undef ATT_LOAD
    if (wact) {
        lsum += __shfl_xor(lsum, 16); lsum += __shfl_xor(lsum, 32); const float inv = 1.f / lsum;
#pragma unroll
        for (int dt = 0; dt < 4; ++dt) *(u32x2*)(MIX + qrow * DM + h * 64 + 16 * dt + 4 * G) = (u32x2){pk2(O[dt][0] * inv, O[dt][1] * inv), pk2(O[dt][2] * inv, O[dt][3] * inv)};
    }
    __syncthreads();
}

constexpr int N_SSD = 2 * 1032;
constexpr int SL_DT = 0, SL_CUM = 1024, SL_XT = 2048, SL_BN = SL_XT + 4 * 64 * 72 * 2, SL_CN = SL_BN + 64 * 136 * 2, SL_BT = SL_CN + 64 * 136 * 2, SL_CB = SL_BT + 128 * 72 * 2, SL_SS = SL_CB + 64 * 68 * 4, SL_END = SL_SS + 1024;
static_assert(SL_END <= LDS_BYTES, "LDS");
struct SsdUnit { bool smp; int b, c, g, cs; size_t row0; };
__device__ __forceinline__ SsdUnit ssd_decode(int u) { SsdUnit s; s.g = u & 1; const int cs = u >> 1; s.cs = cs; s.smp = cs >= 1024;
    if (s.smp) { s.b = cs - 1024; s.c = 0; s.row0 = (size_t)MP + (size_t)s.b * 64; } else { s.b = cs >> 6; s.c = cs & 63; s.row0 = (size_t)cs * 64; } return s; }

template <bool OUTP>
__device__ __forceinline__ void ssd_stage(const Params& p, unsigned char* lds, const SsdUnit& U) {
    const int tid = ltid(), wid = tid >> 6, lane = tid & 63;
    const bf16_t* PROJ = (const bf16_t*)(p.ws + WS_PROJ); const float* DT = (const float*)(p.ws + WS_DT);
    bf16_t* XT = (bf16_t*)(lds + SL_XT); bf16_t* BN = (bf16_t*)(lds + SL_BN); bf16_t* CN = (bf16_t*)(lds + SL_CN); bf16_t* BT = (bf16_t*)(lds + SL_BT);
    float* dtl = (float*)(lds + SL_DT); float* cuml = (float*)(lds + SL_CUM);
    const int g = U.g;
    const int xc = lane < 32 ? g * 256 + lane * 8 : (lane < 48 ? 512 + g * 128 + (lane - 32) * 8 : 768 + g * 128 + (lane - 48) * 8);
    const bool act = OUTP || lane < 48;
    if (act) {
        float cw[4][8], cb[8], win[3][8];
#pragma unroll
        for (int k = 0; k < 4; ++k) { const float4 a = *(const float4*)(p.conv_w_d + k * 1024 + xc), bb = *(const float4*)(p.conv_w_d + k * 1024 + xc + 4);
            cw[k][0] = a.x; cw[k][1] = a.y; cw[k][2] = a.z; cw[k][3] = a.w; cw[k][4] = bb.x; cw[k][5] = bb.y; cw[k][6] = bb.z; cw[k][7] = bb.w; }
        { const float4 a = *(const float4*)(p.conv_b_d + xc), bb = *(const float4*)(p.conv_b_d + xc + 4); cb[0] = a.x; cb[1] = a.y; cb[2] = a.z; cb[3] = a.w; cb[4] = bb.x; cb[5] = bb.y; cb[6] = bb.z; cb[7] = bb.w; }
        const int t0 = wid * 8;
#pragma unroll
        for (int k = 0; k < 3; ++k) { const int tt = t0 - 3 + k;
            if (tt >= 0 || (!U.smp && U.c > 0)) { const u32x4 vv = *(const u32x4*)(PROJ + (size_t)((long)U.row0 + tt) * NCD + 2048 + xc); UNPACK8(vv, win[k]); }
            else if (U.smp) { const float* hp = p.state_conv_d + ((size_t)U.b * 3 + (3 + tt)) * 1024 + xc; const float4 a = *(const float4*)hp, bb = *(const float4*)(hp + 4);
                win[k][0] = a.x; win[k][1] = a.y; win[k][2] = a.z; win[k][3] = a.w; win[k][4] = bb.x; win[k][5] = bb.y; win[k][6] = bb.z; win[k][7] = bb.w; }
            else {
#pragma unroll
                for (int e = 0; e < 8; ++e) win[k][e] = 0.f; } }
#pragma unroll
        for (int i = 0; i < 8; ++i) { const int t = t0 + i; const u32x4 vv = *(const u32x4*)(PROJ + (U.row0 + t) * NCD + 2048 + xc); float cur[8], o[8]; UNPACK8(vv, cur);
#pragma unroll
            for (int e = 0; e < 8; ++e) { o[e] = silu_f(cw[0][e] * win[0][e] + cw[1][e] * win[1][e] + cw[2][e] * win[2][e] + cw[3][e] * cur[e] + cb[e]); win[0][e] = win[1][e]; win[1][e] = win[2][e]; win[2][e] = cur[e]; }
            if (lane < 32) { const int hh = lane >> 3, pp = (lane & 7) * 8;
#pragma unroll
                for (int e = 0; e < 8; ++e) XT[(hh * 64 + pp + e) * 72 + t] = f2bf(o[e]); }
            else if (lane < 48) { const int n = (lane - 32) * 8;
                if (OUTP) *(u32x4*)(BN + t * 136 + n) = PACK8(o);
                else {
#pragma unroll
                    for (int e = 0; e < 8; ++e) BT[(n + e) * 72 + t] = f2bf(o[e]); } }
            else { const int n = (lane - 48) * 8; *(u32x4*)(CN + t * 136 + n) = PACK8(o); } }
    }
    if (wid < 4) { const int h = g * 4 + wid; const float x = DT[(U.row0 + lane) * 8 + h] + p.dt_bias_d[h];
        const float dt = fmaxf(x, 0.f) + log1pf(expf(-fabsf(x))); const float A = -expf(p.a_log_d[h]); float a = dt * A;
#pragma unroll
        for (int o = 1; o < 64; o <<= 1) { const float y = __shfl_up(a, o); if (lane >= o) a += y; }
        dtl[wid * 64 + lane] = dt; cuml[wid * 64 + lane] = a; }
}

__device__ __forceinline__ void ssd_state_unit(const Params& p, unsigned char* lds, int u) {
    const int tid = ltid(), wid = tid >> 6, lane = tid & 63, fr = lane & 15, G = lane >> 4;
    const SsdUnit U = ssd_decode(u);
    ssd_stage<false>(p, lds, U);
    __syncthreads();
    const bf16_t* XT = (const bf16_t*)(lds + SL_XT); const bf16_t* BT = (const bf16_t*)(lds + SL_BT);
    const float* dtl = (const float*)(lds + SL_DT); const float* cuml = (const float*)(lds + SL_CUM);
    float* SB = (float*)(p.ws + WS_SBUF); float* DEC = (float*)(p.ws + WS_DEC);
    const int hh = wid >> 1, half = wid & 1, h = U.g * 4 + hh; const float cumQ = cuml[hh * 64 + 63];
    f32x4 acc[2][8];
#pragma unroll
    for (int pt = 0; pt < 2; ++pt)
#pragma unroll
        for (int nt = 0; nt < 8; ++nt) acc[pt][nt] = (f32x4){0.f, 0.f, 0.f, 0.f};
#pragma unroll
    for (int ks = 0; ks < 2; ++ks) { const int s0 = 32 * ks + 8 * G; float w[8];
        { const float4 d0 = *(const float4*)(dtl + hh * 64 + s0), d1 = *(const float4*)(dtl + hh * 64 + s0 + 4), c0 = *(const float4*)(cuml + hh * 64 + s0), c1 = *(const float4*)(cuml + hh * 64 + s0 + 4);
          w[0] = d0.x * __expf(cumQ - c0.x); w[1] = d0.y * __expf(cumQ - c0.y); w[2] = d0.z * __expf(cumQ - c0.z); w[3] = d0.w * __expf(cumQ - c0.w);
          w[4] = d1.x * __expf(cumQ - c1.x); w[5] = d1.y * __expf(cumQ - c1.y); w[6] = d1.z * __expf(cumQ - c1.z); w[7] = d1.w * __expf(cumQ - c1.w); }
        bf16x8 xb[2];
#pragma unroll
        for (int pt = 0; pt < 2; ++pt) { const u32x4 raw = *(const u32x4*)(XT + (hh * 64 + 32 * half + 16 * pt + fr) * 72 + s0); float f[8]; UNPACK8(raw, f);
#pragma unroll
            for (int e = 0; e < 8; ++e) f[e] *= w[e];
            xb[pt] = as_bf16x8(PACK8(f)); }
#pragma unroll
        for (int nt = 0; nt < 8; ++nt) { const bf16x8 a = *(const bf16x8*)(BT + (16 * nt + fr) * 72 + s0);
#pragma unroll
            for (int pt = 0; pt < 2; ++pt) acc[pt][nt] = MFMA16(a, xb[pt], acc[pt][nt]); } }
#pragma unroll
    for (int pt = 0; pt < 2; ++pt)
#pragma unroll
        for (int nt = 0; nt < 8; ++nt) { const int pp = 32 * half + 16 * pt + fr, n = 16 * nt + 4 * G; *(f32x4*)(SB + (((size_t)U.cs * 8 + h) * 64 + pp) * 128 + n) = acc[pt][nt]; }
    if (half == 0 && lane == 0) DEC[U.cs * 8 + h] = expf(cumQ);
    __syncthreads();
}

__device__ __forceinline__ void phase_scan(const Params& p) {
    const float* SB = (const float*)(p.ws + WS_SBUF); const float* DEC = (const float*)(p.ws + WS_DEC); bf16_t* HIN = (bf16_t*)(p.ws + WS_XN);
    for (int e = blockIdx.x * 512 + ltid(); e < 131072 + 65536; e += gridDim.x * 512) {
        if (e < 131072) { const int bb = e >> 13, off = (e & 8191) * 8, h = off >> 13; float hs[8];
#pragma unroll
            for (int k = 0; k < 8; ++k) hs[k] = 0.f;
            for (int c0 = 0; c0 < 64; c0 += 8) { float4 sa[8], sb[8]; float d[8];
#pragma unroll
                for (int i = 0; i < 8; ++i) { const size_t cs = (size_t)bb * 64 + c0 + i; sa[i] = *(const float4*)(SB + cs * 65536 + off); sb[i] = *(const float4*)(SB + cs * 65536 + off + 4); d[i] = DEC[cs * 8 + h]; }
#pragma unroll
                for (int i = 0; i < 8; ++i) { const size_t cs = (size_t)bb * 64 + c0 + i; *(u32x4*)(HIN + cs * 65536 + off) = PACK8(hs);
                    hs[0] = d[i] * hs[0] + sa[i].x; hs[1] = d[i] * hs[1] + sa[i].y; hs[2] = d[i] * hs[2] + sa[i].z; hs[3] = d[i] * hs[3] + sa[i].w;
                    hs[4] = d[i] * hs[4] + sb[i].x; hs[5] = d[i] * hs[5] + sb[i].y; hs[6] = d[i] * hs[6] + sb[i].z; hs[7] = d[i] * hs[7] + sb[i].w; } }
            float* o = p.out + O_SSM_P + (size_t)bb * 65536 + off; *(float4*)o = make_float4(hs[0], hs[1], hs[2], hs[3]); *(float4*)(o + 4) = make_float4(hs[4], hs[5], hs[6], hs[7]);
        } else { const int e2 = e - 131072, sb_ = e2 >> 13, off = (e2 & 8191) * 8, h = off >> 13; const size_t cs = 1024 + sb_;
            const float* h0 = p.state_ssm_d + (size_t)sb_ * 65536 + off; const float4 a = *(const float4*)h0, b = *(const float4*)(h0 + 4);
            float hs[8] = {a.x, a.y, a.z, a.w, b.x, b.y, b.z, b.w};
            const float4 sa = *(const float4*)(SB + cs * 65536 + off), sb = *(const float4*)(SB + cs * 65536 + off + 4); const float d = DEC[cs * 8 + h];
            *(u32x4*)(HIN + cs * 65536 + off) = PACK8(hs);
            float* o = p.out + O_SSM_S + (size_t)sb_ * 65536 + off;
            *(float4*)o = make_float4(d * hs[0] + sa.x, d * hs[1] + sa.y, d * hs[2] + sa.z, d * hs[3] + sa.w); *(float4*)(o + 4) = make_float4(d * hs[4] + sb.x, d * hs[5] + sb.y, d * hs[6] + sb.z, d * hs[7] + sb.w); }
    }
}

__device__ __forceinline__ void ssd_out_unit(const Params& p, unsigned char* lds, int u) {
    const int tid = ltid(), wid = tid >> 6, lane = tid & 63, fr = lane & 15, G = lane >> 4;
    const SsdUnit U = ssd_decode(u);
    ssd_stage<true>(p, lds, U);
    __syncthreads();
    const bf16_t* PROJ = (const bf16_t*)(p.ws + WS_PROJ); bf16_t* MIX = (bf16_t*)(p.ws + WS_MIX); const bf16_t* HIN = (const bf16_t*)(p.ws + WS_XN);
    const bf16_t* XT = (const bf16_t*)(lds + SL_XT); const bf16_t* BN = (const bf16_t*)(lds + SL_BN); const bf16_t* CN = (const bf16_t*)(lds + SL_CN);
    const float* dtl = (const float*)(lds + SL_DT); const float* cuml = (const float*)(lds + SL_CUM); float* CB = (float*)(lds + SL_CB); float* SS = (float*)(lds + SL_SS);
    for (int idx = wid; idx < 10; idx += 8) { const int tt = idx < 1 ? 0 : (idx < 3 ? 1 : (idx < 6 ? 2 : 3)), st = idx - (tt * (tt + 1)) / 2;
        f32x4 acc = (f32x4){0.f, 0.f, 0.f, 0.f};
#pragma unroll
        for (int ks = 0; ks < 4; ++ks) { const bf16x8 a = *(const bf16x8*)(BN + (16 * st + fr) * 136 + 32 * ks + 8 * G), bq = *(const bf16x8*)(CN + (16 * tt + fr) * 136 + 32 * ks + 8 * G); acc = MFMA16(a, bq, acc); }
        *(f32x4*)(CB + (16 * tt + fr) * 68 + 16 * st + 4 * G) = acc; }
    __syncthreads();
    const int hh = wid >> 1, half = wid & 1, h = U.g * 4 + hh;
    f32x4 acc1[2][4], acc2[2][4];
#pragma unroll
    for (int a = 0; a < 2; ++a)
#pragma unroll
        for (int b = 0; b < 4; ++b) { acc1[a][b] = (f32x4){0.f, 0.f, 0.f, 0.f}; acc2[a][b] = (f32x4){0.f, 0.f, 0.f, 0.f}; }
#pragma unroll
    for (int tt2 = 0; tt2 < 2; ++tt2) { const int ttile = 2 * half + tt2, t = 16 * ttile + fr; const float ct = cuml[hh * 64 + t];
#pragma unroll
        for (int ks = 0; ks < 2; ++ks) { if (32 * ks <= 16 * ttile + 15) { const int s0 = 32 * ks + 8 * G;
            const f32x4 cb0 = *(const f32x4*)(CB + t * 68 + s0), cb1 = *(const f32x4*)(CB + t * 68 + s0 + 4);
            const float4 d0 = *(const float4*)(dtl + hh * 64 + s0), d1 = *(const float4*)(dtl + hh * 64 + s0 + 4), c0 = *(const float4*)(cuml + hh * 64 + s0), c1 = *(const float4*)(cuml + hh * 64 + s0 + 4);
            float mm[8];
            mm[0] = (s0 + 0 <= t) ? cb0[0] * __expf(ct - c0.x) * d0.x : 0.f; mm[1] = (s0 + 1 <= t) ? cb0[1] * __expf(ct - c0.y) * d0.y : 0.f;
            mm[2] = (s0 + 2 <= t) ? cb0[2] * __expf(ct - c0.z) * d0.z : 0.f; mm[3] = (s0 + 3 <= t) ? cb0[3] * __expf(ct - c0.w) * d0.w : 0.f;
            mm[4] = (s0 + 4 <= t) ? cb1[0] * __expf(ct - c1.x) * d1.x : 0.f; mm[5] = (s0 + 5 <= t) ? cb1[1] * __expf(ct - c1.y) * d1.y : 0.f;
            mm[6] = (s0 + 6 <= t) ? cb1[2] * __expf(ct - c1.z) * d1.z : 0.f; mm[7] = (s0 + 7 <= t) ? cb1[3] * __expf(ct - c1.w) * d1.w : 0.f;
            const bf16x8 mb = as_bf16x8(PACK8(mm));
#pragma unroll
            for (int pt = 0; pt < 4; ++pt) { const bf16x8 a = *(const bf16x8*)(XT + (hh * 64 + 16 * pt + fr) * 72 + s0); acc1[tt2][pt] = MFMA16(a, mb, acc1[tt2][pt]); } } } }
    { const bf16_t* hb = HIN + ((size_t)U.cs * 8 + h) * 8192;
#pragma unroll
      for (int ks = 0; ks < 4; ++ks) { bf16x8 bq[2];
#pragma unroll
          for (int tt2 = 0; tt2 < 2; ++tt2) bq[tt2] = *(const bf16x8*)(CN + (16 * (2 * half + tt2) + fr) * 136 + 32 * ks + 8 * G);
#pragma unroll
          for (int pt = 0; pt < 4; ++pt) { const bf16x8 a = *(const bf16x8*)(hb + (16 * pt + fr) * 128 + 32 * ks + 8 * G);
#pragma unroll
              for (int tt2 = 0; tt2 < 2; ++tt2) acc2[tt2][pt] = MFMA16(a, bq[tt2], acc2[tt2][pt]); } } }
    const float dsk = p.d_skip_d[h];
#pragma unroll
    for (int tt2 = 0; tt2 < 2; ++tt2) { const int t = 16 * (2 * half + tt2) + fr; const float et = __expf(cuml[hh * 64 + t]); float ss = 0.f;
#pragma unroll
        for (int pt = 0; pt < 4; ++pt) { const int pp = 16 * pt + 4 * G; const u32x2 zz = *(const u32x2*)(PROJ + (U.row0 + t) * NCD + 1536 + h * 64 + pp);
            const float zf[4] = {bflo(zz[0]), bfhi(zz[0]), bflo(zz[1]), bfhi(zz[1])};
#pragma unroll
            for (int r = 0; r < 4; ++r) { const float xv = bflo((unsigned)XT[(hh * 64 + pp + r) * 72 + t]); float y = acc1[tt2][pt][r] + et * acc2[tt2][pt][r] + dsk * xv; y *= silu_f(zf[r]); acc1[tt2][pt][r] = y; ss += y * y; } }
        ss += __shfl_xor(ss, 16); ss += __shfl_xor(ss, 32);
        if (G == 0) SS[hh * 64 + t] = ss; }
    __syncthreads();
#pragma unroll
    for (int tt2 = 0; tt2 < 2; ++tt2) { const int t = 16 * (2 * half + tt2) + fr; const float tot = SS[t] + SS[64 + t] + SS[128 + t] + SS[192 + t]; const float rstd = rsqrtf(tot * (1.f / 256.f) + 1e-5f);
#pragma unroll
        for (int pt = 0; pt < 4; ++pt) { const int pp = 16 * pt + 4 * G; const float4 ng = *(const float4*)(p.norm_g_d + h * 64 + pp);
            *(u32x2*)(MIX + (U.row0 + t) * DM + 512 + h * 64 + pp) = (u32x2){pk2(acc1[tt2][pt][0] * rstd * ng.x, acc1[tt2][pt][1] * rstd * ng.y), pk2(acc1[tt2][pt][2] * rstd * ng.z, acc1[tt2][pt][3] * rstd * ng.w)}; } }
    __syncthreads();
}

#define PHASE(n, ...) if (p.ph_lo <= (n) && (n) < p.ph_hi) { if ((n) > p.ph_lo) grid.sync(); if (PHM & (1u << (n))) { __VA_ARGS__; } }
__global__ void __launch_bounds__(512, 2) mega(Params p) {
    extern __shared__ __attribute__((aligned(16))) unsigned char lds[];
    cg::grid_group grid = cg::this_grid();
    bf16_t* XN = (bf16_t*)(p.ws + WS_XN); bf16_t* PROJ = (bf16_t*)(p.ws + WS_PROJ); bf16_t* MIX = (bf16_t*)(p.ws + WS_MIX);
    float* H = p.out; float* HS = p.out + (size_t)MP * DM;
    const bf16_t* WGU = (const bf16_t*)(p.ws + WS_WT_GU); const bf16_t* WDN = (const bf16_t*)(p.ws + WS_WT_DN);
    PHASE(0, phase_prep(p, lds); phase_rmsnorm<false>(p, lds, p.x_prompt, p.x_sample, p.norm_mix))
    PHASE(1, run_gemm(lds, XN, (const bf16_t*)(p.ws + WS_WT_INAB), NAB, DM, EpiProjAB{PROJ}))
    PHASE(2, phase_mixer_ab(p, lds))
    PHASE(3, run_gemm(lds, MIX, (const bf16_t*)(p.ws + WS_WT_OUTAB), DM, DM, EpiRes{H, p.x_prompt, p.x_sample}))
    PHASE(4, phase_rmsnorm<false>(p, lds, H, HS, p.norm_ffn))
    PHASE(5, run_gemm(lds, XN, WGU, 2 * FH, DM, EpiSwiglu{PROJ}))
    PHASE(6, run_gemm(lds, PROJ, WDN, DM, FH, EpiRes{H, H, HS}))
    PHASE(7, phase_rmsnorm<true>(p, lds, H, HS, p.norm_mix + DM))
    PHASE(8, run_gemm(lds, XN, (const bf16_t*)(p.ws + WS_WT_INCD), NCD, DM, EpiProjCD{PROJ, p.out}))
    PHASE(9, for (int u = blockIdx.x; u < N_ATT + N_SSD; u += gridDim.x) { if (u < N_ATT) { const int w = u < 4096 ? ((u & 7) * 512 + (u >> 3)) : u; att_unit(p, lds, w); } else ssd_state_unit(p, lds, u - N_ATT); })
    PHASE(10, phase_scan(p))
    PHASE(11, for (int u = blockIdx.x; u < N_SSD; u += gridDim.x) ssd_out_unit(p, lds, u))
    PHASE(12, run_gemm(lds, MIX, (const bf16_t*)(p.ws + WS_WT_OUTCD), DM, DM, EpiRes{H, H, HS}))
    PHASE(13, phase_rmsnorm<false>(p, lds, H, HS, p.norm_ffn + DM))
    PHASE(14, run_gemm(lds, XN, WGU + (size_t)2 * FH * DM, 2 * FH, DM, EpiSwiglu{PROJ}))
    PHASE(15, run_gemm(lds, PROJ, WDN + (size_t)DM * FH, DM, FH, EpiRes{H, H, HS}))
    PHASE(16, phase_final_norm(p))
}

extern "C" void kernel_launch(void* const* d_in, const int* in_sizes, int n_in, void* d_out, int out_size, void* d_ws, size_t ws_size, hipStream_t stream) {
    static int grid = 0;
    if (grid == 0) {
        int dev = 0, cus = 0, per_cu = 0;
        hipGetDevice(&dev); hipDeviceGetAttribute(&cus, hipDeviceAttributeMultiprocessorCount, dev);
        if (hipFuncSetAttribute((const void*)mega, hipFuncAttributeMaxDynamicSharedMemorySize, LDS_BYTES) != hipSuccess) fprintf(stderr, "kernel_launch: hipFuncSetAttribute failed\n");
        if (hipOccupancyMaxActiveBlocksPerMultiprocessor(&per_cu, (const void*)mega, 512, LDS_BYTES) != hipSuccess || per_cu < 1) { fprintf(stderr, "kernel_launch: occupancy query gave %d\n", per_cu); per_cu = 1; }
        (void)hipGetLastError();
        if (cus <= 0) cus = 256;
        grid = cus;
        if (n_in != 29 || (size_t)out_size != O_END || ws_size < WS_END) fprintf(stderr, "kernel_launch: unexpected sizes n_in %d out %d ws %zu (need %zu)\n", n_in, out_size, ws_size, (size_t)WS_END);
    }
    Params p{};
    const float** pp = (const float**)&p;
    for (int i = 0; i < 29; ++i) pp[i] = (const float*)d_in[i];
    p.out = (float*)d_out; p.ws = (unsigned char*)d_ws;
#if PER_PHASE_LAUNCH
    for (int ph = 0; ph < NPH; ++ph) { p.ph_lo = ph; p.ph_hi = ph + 1; hipLaunchKernelGGL(mega, dim3(grid), dim3(512), LDS_BYTES, stream, p); }
#else
    p.ph_lo = 0; p.ph_hi = NPH; void* args[] = {&p};
    hipError_t e = hipLaunchCooperativeKernel((const void*)mega, dim3(grid), dim3(512), args, LDS_BYTES, stream);
    if (e != hipSuccess) fprintf(stderr, "kernel_launch: cooperative launch failed: %s (grid %d)\n", hipGetErrorString(e), grid);
#endif
}
```

```cpp
#include <hip/hip_runtime.h>
#include <hip/hip_cooperative_groups.h>
#include <cstdio>
namespace cg = cooperative_groups;
#ifndef PER_PHASE_LAUNCH
#define PER_PHASE_LAUNCH 0
#endif
namespace pg8 {
#define PG8_LAS __attribute__((address_space(3)))
typedef unsigned short bf16_t;
typedef short bf16x8 __attribute__((ext_vector_type(8)));
typedef float f32x4 __attribute__((ext_vector_type(4)));
typedef unsigned u32x4 __attribute__((ext_vector_type(4)));
constexpr int BM = 256, BK = 64, HALF = 128, HTB = HALF * BK * 2  , STAGE_BYTES = 8 * HTB, NXCD = 8, WGM = 4;

__host__ __device__ __forceinline__ int lds_byte(int r, int c) { const int st = (r >> 4) * 2 + (c >> 5), rr = r & 15, cc = c & 31, ob = rr * 64 + cc * 2; return st * 1024 + (ob ^ (((ob >> 9) & 1) << 5)); }
__host__ __device__ __forceinline__ void stage_rc(int b, int& R, int& C) { const int st = b / 1024, sb = b % 1024, swz = sb ^ (((sb >> 9) & 1) << 5); R = (st >> 1) * 16 + swz / 64; C = (st & 1) * 32 + (swz % 64) / 2; }
__host__ __device__ __forceinline__ int perm32(int rho) { const int n = rho >> 4, i = rho & 15; return 8 * (i >> 2) + 4 * n + (i & 3); }

struct Unit { int pm, pn; };
struct Gemm { const bf16_t* A; const bf16_t* Bt; int M, N, K; };

struct StaticOrder {
    int nM, nN, nwg, G, c;
    __host__ __device__ void init(int M, int N, int G_, int c_) { nM = M / BM; nN = N / BM; nwg = nM * nN; G = G_; c = c_; }
    __host__ __device__ bool next(int i, Unit& u) const {
        const long L = (long)i * G + c; if (L >= nwg) return false;
        int wgid = (int)L; { const int q = nwg / NXCD, r = nwg % NXCD, xcd = wgid % NXCD, off = wgid / NXCD; wgid = (xcd < r ? xcd * (q + 1) : r * (q + 1) + (xcd - r) * q) + off; }
        const int nig = WGM * nN, gid = wgid / nig, fm = gid * WGM, gsz = (nM - fm) < WGM ? (nM - fm) : WGM;
        u.pm = fm + ((wgid % nig) % gsz); u.pn = (wgid % nig) / gsz; return true;
    }
    __device__ __forceinline__ void a_ready(const Unit&) const {}
    __device__ __forceinline__ void done(const Unit&) const {}
};
__device__ __forceinline__ unsigned cvt_pk_bf16(float lo, float hi) { unsigned r; asm volatile("v_cvt_pk_bf16_f32 %0, %1, %2" : "=v"(r) : "v"(lo), "v"(hi)); return r; }
typedef float f32x2 __attribute__((ext_vector_type(2)));
__device__ __forceinline__ f32x2 gelu_pk(f32x2 v) {
    const f32x2 av = __builtin_elementwise_abs(v), d = av * 0.2316418882f + 1.0f;
    f32x2 t; t.x = __builtin_amdgcn_rcpf(d.x); t.y = __builtin_amdgcn_rcpf(d.y);
    f32x2 q = t * 0.5307027145f + (-0.7265760135f); q = q * t + 0.7107068705f; q = q * t + (-0.142248368f); q = q * t + 0.127414796f; q = q * t;
    const f32x2 s = (v * v) * (-0.72134752044f);
    f32x2 e; e.x = __builtin_amdgcn_exp2f(s.x); e.y = __builtin_amdgcn_exp2f(s.y);
    const f32x2 m = v * (q * e), r = v - m;
    f32x2 o; o.x = v.x < 0.f ? m.x : r.x; o.y = v.y < 0.f ? m.y : r.y; return o;
}
template <class Epi, class Sched, bool STAMP = false>
__device__ __forceinline__ void gemm_phase(PG8_LAS unsigned char* lds, const Gemm g, const Sched& S, const Epi& E, unsigned long long* stamps) {
    int tid_l = threadIdx.x; asm volatile("" : "+v"(tid_l)); const int tid = tid_l, wid = __builtin_amdgcn_readfirstlane(tid >> 6), lane = tid & 63, wr = wid >> 2, wc = wid & 3, fr = lane & 15, fq = lane >> 4;
    const int K = g.K, nt = K / BK;
    int ts_lo = 0, ts_hi = 0, nts = 0; const unsigned long long rt_entry = STAMP ? (unsigned long long)wall_clock64() : 0ull;
#define PG8_STAMP() do { if (STAMP && wid == 0 && nts < 64) { const unsigned long long _c = (unsigned long long)clock64(); \
        ts_lo = (lane == nts) ? (int)(unsigned)_c : ts_lo; ts_hi = (lane == nts) ? (int)(unsigned)(_c >> 32) : ts_hi; ++nts; } } while (0)
    PG8_STAMP();
    unsigned voffA[2], voffB[2];
#pragma unroll
    for (int i = 0; i < 2; ++i) { int R, C; stage_rc(tid * 16 + i * 8192, R, C); const int Rb = Epi::PERM ? ((R & ~31) + perm32(R & 31)) : R;
        voffA[i] = (unsigned)(R * K + C) * 2u; voffB[i] = (unsigned)(Rb * K + C) * 2u; }
    const size_t kstep = (size_t)(BK * 2);
    const size_t hstep = (size_t)HALF * K * 2;
    const size_t tstep = 2 * hstep;
    const unsigned ldsw = (unsigned)wid * 1024u;
    const int aoff = lds_byte(wr * 64 + fr, fq * 8), boff = lds_byte(wc * 32 + fr, fq * 8);
#define PG8_SA(b, h) (((b) * 2 + (h)) * HTB)
#define PG8_SB(b, h) ((4 + (b) * 2 + (h)) * HTB)
#define PG8_STAGE(bufoff, gbase, voff) do { _Pragma("unroll") for (int _i = 0; _i < 2; ++_i) \
        __builtin_amdgcn_global_load_lds((const unsigned*)((const char*)(gbase) + (voff)[_i]), (PG8_LAS unsigned*)(lds + (bufoff) + ldsw + _i * 8192), 16, 0, 0); } while (0)
#define PG8_LDA(dst, b, h) do { _Pragma("unroll") for (int m = 0; m < 4; ++m) _Pragma("unroll") for (int k = 0; k < 2; ++k) dst[m][k] = *(const PG8_LAS bf16x8*)(lds + PG8_SA(b, h) + aoff + m * 2048 + k * 1024); } while (0)
#define PG8_LDB(dst, b, h) do { _Pragma("unroll") for (int n = 0; n < 2; ++n) _Pragma("unroll") for (int k = 0; k < 2; ++k) dst[n][k] = *(const PG8_LAS bf16x8*)(lds + PG8_SB(b, h) + boff + n * 2048 + k * 1024); } while (0)
#define PG8_MMA(ai, bj, At, Bt) do { __builtin_amdgcn_s_setprio(1); _Pragma("unroll") for (int m = 0; m < 4; ++m) _Pragma("unroll") for (int n = 0; n < 2; ++n) _Pragma("unroll") for (int k = 0; k < 2; ++k) \
        acc[ai][bj][m][n] = __builtin_amdgcn_mfma_f32_16x16x32_bf16(Bt[n][k], At[m][k], acc[ai][bj][m][n], 0, 0, 0); __builtin_amdgcn_s_setprio(0); } while (0)
#define PG8_WAIT_V(n) asm volatile("s_waitcnt vmcnt(" #n ")" ::: "memory")
#define PG8_WAIT_L(n) asm volatile("s_waitcnt lgkmcnt(" #n ")" ::: "memory")
#define PG8_BAR __builtin_amdgcn_s_barrier()
#define PG8_SCHED __builtin_amdgcn_sched_barrier(0)
    Unit cur, nxt; int ui = 0;
    if (!S.next(0, cur)) return;
    f32x4 acc[2][2][4][2];
#pragma unroll
    for (int a = 0; a < 2; ++a)
#pragma unroll
        for (int b = 0; b < 2; ++b)
#pragma unroll
            for (int m = 0; m < 4; ++m)
#pragma unroll
                for (int n = 0; n < 2; ++n) acc[a][b][m][n] = (f32x4){0.f, 0.f, 0.f, 0.f};
    bf16x8 At[4][2], B0[2][2], B1[2][2];
    const char* cA = (const char*)g.A + (size_t)cur.pm * tstep; const char* cB = (const char*)g.Bt + (size_t)cur.pn * tstep;
    S.a_ready(cur);
    PG8_STAGE(PG8_SB(0, 0), cB, voffB); PG8_STAGE(PG8_SA(0, 0), cA, voffA); PG8_STAGE(PG8_SB(0, 1), cB + hstep, voffB); PG8_STAGE(PG8_SA(0, 1), cA + hstep, voffA);
    if (wr == 1) PG8_BAR;
    PG8_WAIT_V(4); PG8_BAR;
    PG8_STAGE(PG8_SB(1, 0), cB + kstep, voffB); PG8_STAGE(PG8_SA(1, 0), cA + kstep, voffA); PG8_STAGE(PG8_SB(1, 1), cB + hstep + kstep, voffB);
    PG8_WAIT_V(6); PG8_BAR;
    PG8_STAMP();
    for (;;) {
        const bool has_next = S.next(ui + 1, nxt);
        const char* nA = has_next ? (const char*)g.A + (size_t)nxt.pm * tstep : cA; const char* nB = has_next ? (const char*)g.Bt + (size_t)nxt.pn * tstep : cB;
        for (int t = 0; t < nt; t += 2) {
            const bool last = (t == nt - 2);
            const char* a1 = cA + (size_t)(t + 1) * kstep;
            const char* a2 = last ? nA : cA + (size_t)(t + 2) * kstep; const char* b2 = last ? nB : cB + (size_t)(t + 2) * kstep;
            const char* a3 = a2 + kstep; const char* b3 = b2 + kstep;
            if (last && has_next) S.a_ready(nxt);
            PG8_LDB(B0, 0, 0); PG8_SCHED; PG8_LDA(At, 0, 0); PG8_STAGE(PG8_SA(1, 1), a1 + hstep, voffA);
            PG8_WAIT_L(8); PG8_BAR; PG8_WAIT_L(0); PG8_MMA(0, 0, At, B0); PG8_BAR; PG8_SCHED;
            PG8_LDB(B1, 0, 1); PG8_STAGE(PG8_SB(0, 0), b2, voffB);
            PG8_BAR; PG8_WAIT_L(0); PG8_MMA(0, 1, At, B1); PG8_BAR;
            PG8_LDA(At, 0, 1); PG8_STAGE(PG8_SA(0, 0), a2, voffA);
            PG8_BAR; PG8_WAIT_L(0); PG8_MMA(1, 0, At, B0); PG8_BAR; PG8_SCHED;
            PG8_STAGE(PG8_SB(0, 1), b2 + hstep, voffB);
            PG8_WAIT_V(6); PG8_BAR; PG8_MMA(1, 1, At, B1); PG8_BAR;
            PG8_LDB(B0, 1, 0); PG8_SCHED; PG8_LDA(At, 1, 0); PG8_STAGE(PG8_SA(0, 1), a2 + hstep, voffA);
            PG8_WAIT_L(8); PG8_BAR; PG8_WAIT_L(0); PG8_MMA(0, 0, At, B0); PG8_BAR; PG8_SCHED;
            PG8_LDB(B1, 1, 1); PG8_STAGE(PG8_SB(1, 0), b3, voffB);
            PG8_BAR; PG8_WAIT_L(0); PG8_MMA(0, 1, At, B1); PG8_BAR;
            PG8_LDA(At, 1, 1); PG8_STAGE(PG8_SA(1, 0), a3, voffA);
            PG8_BAR; PG8_WAIT_L(0); PG8_MMA(1, 0, At, B0); PG8_BAR; PG8_SCHED;
            PG8_STAGE(PG8_SB(1, 1), b3 + hstep, voffB);
            PG8_WAIT_V(6); PG8_BAR; PG8_MMA(1, 1, At, B1); PG8_BAR;
        }
        PG8_STAMP();
        if constexpr (!Epi::AFTER_DRAIN) { E(acc, cur, wr, wc, fr, fq); S.done(cur); }
        PG8_STAMP();
        if (!has_next) break;
#pragma unroll
        for (int a = 0; a < 2; ++a)
#pragma unroll
            for (int b = 0; b < 2; ++b)
#pragma unroll
                for (int m = 0; m < 4; ++m)
#pragma unroll
                    for (int n = 0; n < 2; ++n) acc[a][b][m][n] = (f32x4){0.f, 0.f, 0.f, 0.f};
        cur = nxt; cA = nA; cB = nB; ++ui;
    }
    PG8_WAIT_V(0);
    if (wr == 0) PG8_BAR;
    PG8_BAR;
    if constexpr (Epi::AFTER_DRAIN) { E.fused(acc, cur, wr, wc, fr, fq, lds, wid, lane); S.done(cur); }
    PG8_STAMP();
    if (STAMP && wid == 0) { stamps[lane] = lane < nts ? (((unsigned long long)(unsigned)ts_hi << 32) | (unsigned)ts_lo) : 0ull;
        if (lane == 62) stamps[62] = rt_entry; if (lane == 63) stamps[63] = (unsigned long long)wall_clock64(); }
#undef PG8_STAMP
#undef PG8_SA
#undef PG8_SB
#undef PG8_STAGE
#undef PG8_LDA
#undef PG8_LDB
#undef PG8_MMA
#undef PG8_WAIT_V
#undef PG8_WAIT_L
#undef PG8_BAR
#undef PG8_SCHED
}
}
#define XB_TMO      128
#define XB_XCNT(j)  (256  + 64 * (j))
#define XB_XSUB(j)  (1280 + 64 * (j))
#define XB_XGEN(j)  (2304 + 64 * (j))
#define XB_TOP      3328
#define XB_TOPGEN   3392
#define XCD_BAR_WORDS 3456
#define XB_SPIN_CAP (1u << 18)
#define LAS __attribute__((address_space(3)))

__device__ __forceinline__ unsigned xb_ld(unsigned* p)              { return __hip_atomic_load(p, __ATOMIC_RELAXED, __HIP_MEMORY_SCOPE_AGENT); }
__device__ __forceinline__ unsigned xb_add(unsigned* p, unsigned v) { return __hip_atomic_fetch_add(p, v, __ATOMIC_RELAXED, __HIP_MEMORY_SCOPE_AGENT); }
__device__ __forceinline__ unsigned xb_xcc_id() { return (unsigned)__builtin_amdgcn_s_getreg((3 << 11) | 20) & 0xFu; }
#define XB_SPIN(cond, bar) do { unsigned _sp = 0; while (cond) { __builtin_amdgcn_s_sleep(1); \
    if ((++_sp & 255u) == 0u) { if (xb_ld(&(bar)[XB_TMO])) break; if (_sp > XB_SPIN_CAP) { atomicAdd(&(bar)[XB_TMO], 1u); break; } } } } while (0)

struct XcdBarrier {
    unsigned* bar; unsigned x;
    volatile LAS unsigned* st;
};

__device__ __forceinline__ XcdBarrier xcd_barrier_post(unsigned* bar, volatile LAS unsigned* st) {
    XcdBarrier b; b.bar = bar; b.x = xb_xcc_id(); b.st = st;
    if (threadIdx.x == 0) (void)xb_add(&bar[XB_XCNT(b.x)], 1u);
    return b;
}
__device__ __forceinline__ void xcd_barrier_complete(unsigned* bar, unsigned x, unsigned& nloc, unsigned& nx) {
    const unsigned G = gridDim.x * gridDim.y * gridDim.z;
    unsigned sum, cnt, mine, sp = 0u;
    for (;;) {
        sum = 0u; cnt = 0u; mine = 0u;
#pragma unroll
        for (unsigned j = 0; j < 16; ++j) { const unsigned c = xb_ld(&bar[XB_XCNT(j)]); sum += c; cnt += (c > 0u) ? 1u : 0u; mine = (j == x) ? c : mine; }
        if (sum == G) break;
        __builtin_amdgcn_s_sleep(1);
        if ((++sp & 255u) == 0u) { if (xb_ld(&bar[XB_TMO])) break; if (sp > XB_SPIN_CAP) { atomicAdd(&bar[XB_TMO], 1u); break; } }
    }
    nloc = mine > 0u ? mine : 1u; nx = cnt > 0u ? cnt : 1u;
}

__device__ __forceinline__ void xcd_barrier(const XcdBarrier& b) {
    asm volatile("s_waitcnt vmcnt(0)" ::: "memory");
    __syncthreads();
    if (threadIdx.x == 0) {
        unsigned* bar = b.bar;
        __builtin_amdgcn_s_waitcnt(0);
        unsigned nloc = b.st[0], nx = b.st[1];
        if (nloc == 0u) { xcd_barrier_complete(bar, b.x, nloc, nx); b.st[0] = nloc; b.st[1] = nx; }
        const unsigned old = xb_add(&bar[XB_XSUB(b.x)], 1u);
        const unsigned gen = old / nloc;
        if (old + 1u == (gen + 1u) * nloc) {
            __builtin_amdgcn_fence(__ATOMIC_RELEASE, "agent");
            asm volatile("s_waitcnt vmcnt(0)" ::: "memory");
            const unsigned og = xb_add(&bar[XB_TOP], 1u);
            const unsigned tg = og / nx;
            if (og + 1u == (tg + 1u) * nx) xb_add(&bar[XB_TOPGEN], 1u);
            else XB_SPIN(xb_ld(&bar[XB_TOPGEN]) == tg, bar);
            __builtin_amdgcn_fence(__ATOMIC_ACQUIRE, "agent");
            xb_add(&bar[XB_XGEN(b.x)], 1u);
            asm volatile("s_waitcnt vmcnt(0)" ::: "memory");
        } else {
            XB_SPIN(xb_ld(&bar[XB_XGEN(b.x)]) == gen, bar);
            __builtin_amdgcn_fence(__ATOMIC_ACQUIRE, "agent");
            asm volatile("s_waitcnt vmcnt(0)" ::: "memory");
        }
    }
    __syncthreads();
}


using pg8::bf16_t; using pg8::bf16x8; using pg8::f32x4; using pg8::u32x4; using pg8::f32x2;
typedef unsigned u32x2 __attribute__((ext_vector_type(2)));

constexpr int MP = 65536, MS = 512, MT = MP + MS, DM = 1024;
constexpr int NAB = 2560, NCD = 3072, NCDF = 3080, NCDP = 3328, FH = 2816;
constexpr int NPH = 17;
constexpr float RMS_EPS = 1e-5f;
#ifndef PHM
#define PHM 0xFFFFF
#endif
constexpr int LDS_BYTES = 131072 + 64;

constexpr size_t O_Y_P = 0;
constexpr size_t O_Y_S = O_Y_P + (size_t)MP * DM;
constexpr size_t O_CONVA_P = O_Y_S + (size_t)MS * DM;
constexpr size_t O_CONVA_S = O_CONVA_P + 16 * 2 * 512;
constexpr size_t O_VB_S = O_CONVA_S + 8 * 2 * 512;
constexpr size_t O_KC_P = O_VB_S + 8 * 64 * 512;
constexpr size_t O_VC_P = O_KC_P + (size_t)16 * 512 * 512;
constexpr size_t O_KC_S = O_VC_P + (size_t)16 * 512 * 512;
constexpr size_t O_VC_S = O_KC_S + 8 * 64 * 512;
constexpr size_t O_CONVD_P = O_VC_S + 8 * 64 * 512;
constexpr size_t O_CONVD_S = O_CONVD_P + 16 * 3 * 1024;
constexpr size_t O_SSM_P = O_CONVD_S + 8 * 3 * 1024;
constexpr size_t O_SSM_S = O_SSM_P + (size_t)16 * 65536;
constexpr size_t O_END = O_SSM_S + (size_t)8 * 65536;

constexpr size_t WS_WT_INAB = 0;
constexpr size_t WS_WT_OUTAB = WS_WT_INAB + (size_t)NAB * DM * 2;
constexpr size_t WS_WT_INCD = WS_WT_OUTAB + (size_t)DM * DM * 2;
constexpr size_t WS_WT_OUTCD = WS_WT_INCD + (size_t)NCDP * DM * 2;
constexpr size_t WS_WT_GU = WS_WT_OUTCD + (size_t)DM * DM * 2;
constexpr size_t WS_WT_DN = WS_WT_GU + (size_t)2 * 2 * FH * DM * 2;
constexpr size_t WS_XN = WS_WT_DN + (size_t)2 * DM * FH * 2;
constexpr size_t WS_PROJ = WS_XN + (size_t)MT * DM * 2;
constexpr size_t WS_MIX = WS_PROJ + (size_t)MT * NCD * 2;
constexpr size_t WS_SBUF = WS_MIX + (size_t)MT * DM * 2;
constexpr size_t WS_DT = WS_SBUF + (size_t)1032 * 65536 * 4;
constexpr size_t WS_DEC = WS_DT + (size_t)MT * 8 * 4;
constexpr size_t WS_CK = WS_DEC + (size_t)1032 * 8 * 4 + 128;
constexpr size_t WS_CV = WS_CK + (size_t)8 * 512 * 512 * 2;
constexpr size_t WS_BAR = WS_CV + (size_t)8 * 512 * 512 * 2;
constexpr size_t WS_SS = WS_BAR + 16384;
constexpr size_t WS_HD = WS_SS + (size_t)5 * MT * 8;
constexpr size_t WS_WSB = WS_HD + (size_t)(8 * 3 + 1) * 1024 * 2;
constexpr size_t WS_END = WS_WSB + (size_t)4 * 128 * 128 * 2;

struct Params {
    const float *x_prompt, *x_sample, *cache_k, *cache_v, *state_conv_a, *state_conv_d, *state_ssm_d;
    const float *norm_mix, *norm_ffn, *norm_final, *w_in_ab, *conv_w_a, *ln_g_b, *ln_b_b, *w_s_b, *b_s_b, *w_out_ab, *w_in_cd, *rel_bias_c, *conv_w_d, *conv_b_d,
        *dt_bias_d, *a_log_d, *d_skip_d, *norm_g_d, *w_out_cd, *w_gate, *w_up, *w_down;
    float* out; unsigned char* ws;
    int ph_lo, ph_hi;
};

__device__ __forceinline__ int ltid() { int t = threadIdx.x; asm volatile("" : "+v"(t)); return t; }
__device__ __forceinline__ unsigned pk2(float lo, float hi) { unsigned r; asm("v_cvt_pk_bf16_f32 %0, %1, %2" : "=v"(r) : "v"(lo), "v"(hi)); return r; }
__device__ __forceinline__ unsigned short f2bf(float f) { return (unsigned short)(pk2(f, 0.f) & 0xffffu); }
__device__ __forceinline__ float bflo(unsigned w) { return __uint_as_float(w << 16); }
__device__ __forceinline__ float bfhi(unsigned w) { return __uint_as_float(w & 0xffff0000u); }
#define UNPACK8(v, f) do { f[0] = bflo(v[0]); f[1] = bfhi(v[0]); f[2] = bflo(v[1]); f[3] = bfhi(v[1]); f[4] = bflo(v[2]); f[5] = bfhi(v[2]); f[6] = bflo(v[3]); f[7] = bfhi(v[3]); } while (0)
#define PACK8(f) ((u32x4){pk2(f[0], f[1]), pk2(f[2], f[3]), pk2(f[4], f[5]), pk2(f[6], f[7])})
__device__ __forceinline__ float wave_sum(float v) {
#pragma unroll
    for (int o = 32; o; o >>= 1) v += __shfl_xor(v, o);
    return v;
}
__device__ __forceinline__ float silu_f(float x) { return x * __builtin_amdgcn_rcpf(1.f + __expf(-x)); }
__device__ __forceinline__ bf16x8 as_bf16x8(u32x4 v) { union { u32x4 u; bf16x8 b; } c; c.u = v; return c.b; }
__device__ __forceinline__ int swz8(int row, int col) { return col ^ (((row >> 3) & 7) << 3); }
__device__ __forceinline__ int swz16(int row, int col) { return col ^ (((row >> 3) & 15) << 3); }
__device__ __forceinline__ int swzv(int c, int t) { return t ^ ((((c >> 3) ^ c) & 15) << 3); }
typedef _Float16 h16x2 __attribute__((ext_vector_type(2)));
__device__ __forceinline__ unsigned pkh2(float lo, float hi) { union { h16x2 h; unsigned u; } c; c.h = (h16x2){(_Float16)lo, (_Float16)hi}; return c.u; }
__device__ __forceinline__ float h16lo(unsigned w) { union { h16x2 h; unsigned u; } c; c.u = w; return (float)c.h[0]; }
__device__ __forceinline__ float h16hi(unsigned w) { union { h16x2 h; unsigned u; } c; c.u = w; return (float)c.h[1]; }
#define MFMA16(a, b, c) __builtin_amdgcn_mfma_f32_16x16x32_bf16((a), (b), (c), 0, 0, 0)

typedef unsigned long long ssq_t;
__device__ __forceinline__ ssq_t ssq_fix(float ss) { return (ssq_t)(ss * 1048576.f + 0.5f); }
__device__ __forceinline__ float rstd_of(const ssq_t* SS, int row) { return rsqrtf((float)SS[row] * (1.f / (1048576.f * 1024.f)) + RMS_EPS); }
struct EpiProjAB {
    static constexpr bool PERM = true, AFTER_DRAIN = false;
    bf16_t* O; const ssq_t* SS;
    __device__ __forceinline__ void operator()(const f32x4 (&acc)[2][2][4][2], const pg8::Unit& u, int wr, int wc, int fr, int fq) const {
        const int row0 = u.pm * 256 + wr * 64 + fr, col0 = u.pn * 256 + wc * 32 + 8 * fq;
        const bool act = u.pn >= 6;
#pragma unroll
        for (int ai = 0; ai < 2; ++ai)
#pragma unroll
            for (int m = 0; m < 4; ++m) { const int r = row0 + ai * 128 + m * 16; const float rs = rstd_of(SS, r); bf16_t* rowp = O + (size_t)r * NAB + col0;
#pragma unroll
                for (int bj = 0; bj < 2; ++bj) { f32x4 v0 = acc[ai][bj][m][0] * rs, v1 = acc[ai][bj][m][1] * rs;
                    if (act) { f32x2 a = pg8::gelu_pk((f32x2){v0[0], v0[1]}), b = pg8::gelu_pk((f32x2){v0[2], v0[3]}), c = pg8::gelu_pk((f32x2){v1[0], v1[1]}), d = pg8::gelu_pk((f32x2){v1[2], v1[3]});
                        v0 = (f32x4){a.x, a.y, b.x, b.y}; v1 = (f32x4){c.x, c.y, d.x, d.y}; }
                    *(u32x4*)(rowp + bj * 128) = (u32x4){pk2(v0[0], v0[1]), pk2(v0[2], v0[3]), pk2(v1[0], v1[1]), pk2(v1[2], v1[3])}; } }
    }
};
struct EpiRes {
    static constexpr bool PERM = true, AFTER_DRAIN = false;
    bf16_t* HB; const float* Rf; ssq_t* SSo;
    __device__ __forceinline__ void operator()(const f32x4 (&acc)[2][2][4][2], const pg8::Unit& u, int wr, int wc, int fr, int fq) const {
        const int row0 = u.pm * 256 + wr * 64 + fr, col0 = u.pn * 256 + wc * 32 + 8 * fq;
#pragma unroll
        for (int ai = 0; ai < 2; ++ai)
#pragma unroll
            for (int m = 0; m < 4; ++m) { const int r = row0 + ai * 128 + m * 16; bf16_t* hp = HB + (size_t)r * DM + col0; float ss = 0.f;
#pragma unroll
                for (int bj = 0; bj < 2; ++bj) { f32x4 v0 = acc[ai][bj][m][0], v1 = acc[ai][bj][m][1];
                    if (Rf) { const float* rp = Rf + (size_t)r * DM + col0 + bj * 128; v0 += *(const f32x4*)rp; v1 += *(const f32x4*)(rp + 4); }
                    else { const u32x4 hv = *(const u32x4*)(hp + bj * 128); v0 += (f32x4){bflo(hv[0]), bfhi(hv[0]), bflo(hv[1]), bfhi(hv[1])}; v1 += (f32x4){bflo(hv[2]), bfhi(hv[2]), bflo(hv[3]), bfhi(hv[3])}; }
                    ss += v0[0] * v0[0] + v0[1] * v0[1] + v0[2] * v0[2] + v0[3] * v0[3] + v1[0] * v1[0] + v1[1] * v1[1] + v1[2] * v1[2] + v1[3] * v1[3];
                    *(u32x4*)(hp + bj * 128) = (u32x4){pk2(v0[0], v0[1]), pk2(v0[2], v0[3]), pk2(v1[0], v1[1]), pk2(v1[2], v1[3])}; }
                ss += __shfl_xor(ss, 16); ss += __shfl_xor(ss, 32);
                if (fq == 0) atomicAdd(SSo + r, ssq_fix(ss)); }
    }
};
struct EpiSwiglu {
    static constexpr bool PERM = true, AFTER_DRAIN = false;
    bf16_t* O; const ssq_t* SS;
    __device__ __forceinline__ void operator()(const f32x4 (&acc)[2][2][4][2], const pg8::Unit& u, int wr, int wc, int fr, int fq) const {
        const int row0 = u.pm * 256 + wr * 64 + fr, col0 = u.pn * 128 + wc * 32 + 8 * fq;
#pragma unroll
        for (int ai = 0; ai < 2; ++ai)
#pragma unroll
            for (int m = 0; m < 4; ++m) { const int r = row0 + ai * 128 + m * 16; const float rs = rstd_of(SS, r); bf16_t* rowp = O + (size_t)r * FH + col0;
                const f32x4 g0 = acc[ai][0][m][0] * rs, g1 = acc[ai][0][m][1] * rs, u0 = acc[ai][1][m][0] * rs, u1 = acc[ai][1][m][1] * rs;
                float h[8];
#pragma unroll
                for (int j = 0; j < 4; ++j) { h[j] = silu_f(g0[j]) * u0[j]; h[4 + j] = silu_f(g1[j]) * u1[j]; }
                *(u32x4*)rowp = PACK8(h); }
    }
};
struct EpiProjCD {
    static constexpr bool PERM = true, AFTER_DRAIN = false;
    bf16_t* O; float* out; const ssq_t* SS; float* DT;
    __device__ __forceinline__ void operator()(const f32x4 (&acc)[2][2][4][2], const pg8::Unit& u, int wr, int wc, int fr, int fq) const {
        const int row0 = u.pm * 256 + wr * 64 + fr, col0 = u.pn * 256 + wc * 32 + 8 * fq;
        if (u.pn == 12) {
            if (wc == 0 && fq == 0) {
#pragma unroll
                for (int ai = 0; ai < 2; ++ai)
#pragma unroll
                    for (int m = 0; m < 4; ++m) { const int r = row0 + ai * 128 + m * 16; const float rs = rstd_of(SS, r); *(f32x4*)(DT + (size_t)r * 8) = acc[ai][0][m][0] * rs; *(f32x4*)(DT + (size_t)r * 8 + 4) = acc[ai][0][m][1] * rs; } }
            return; }
        const int pmb = u.pm & 15;
        const bool kv = (u.pn >= 2 && u.pn < 6) && (pmb >= 14), cvd = (u.pn >= 8) && (pmb == 15);
#pragma unroll
        for (int ai = 0; ai < 2; ++ai)
#pragma unroll
            for (int m = 0; m < 4; ++m) { const int r = row0 + ai * 128 + m * 16; const float rs = rstd_of(SS, r); bf16_t* rowp = O + (size_t)r * NCD + col0;
#pragma unroll
                for (int bj = 0; bj < 2; ++bj) { const f32x4 v0 = acc[ai][bj][m][0] * rs, v1 = acc[ai][bj][m][1] * rs;
                    *(u32x4*)(rowp + bj * 128) = (u32x4){pk2(v0[0], v0[1]), pk2(v0[2], v0[3]), pk2(v1[0], v1[1]), pk2(v1[2], v1[3])};
                    if (kv) { const int c = col0 + bj * 128; const bool isv = c >= 1024; const int cc = c - (isv ? 1024 : 512);
                        const int b = r >> 12, t = r & 4095; float* o = out + (isv ? O_VC_P : O_KC_P) + ((size_t)b * 512 + (t - 3584)) * 512 + cc;
                        *(f32x4*)o = v0; *(f32x4*)(o + 4) = v1; }
                    if (cvd) { const int cc = col0 + bj * 128 - 2048; const int b = r >> 12, t = r & 4095;
                        if (t >= 4093) { float* o = out + O_CONVD_P + ((size_t)b * 3 + (t - 4093)) * 1024 + cc; *(f32x4*)o = v0; *(f32x4*)(o + 4) = v1; } } } }
    }
};

template <class Epi> __device__ __forceinline__ void run_gemm(unsigned char* lds, const bf16_t* A, const bf16_t* Bt, int N, int K, const Epi& E, int stagger = 0) {
    if (stagger > 0) { const unsigned long long t0 = __builtin_amdgcn_s_memrealtime(); const unsigned long long off = ((unsigned long long)(__brev((unsigned)blockIdx.x) >> 24) * (unsigned)stagger) >> 8;
        while (__builtin_amdgcn_s_memrealtime() - t0 < off) __builtin_amdgcn_s_sleep(8); }
    pg8::Gemm g{A, Bt, MP, N, K}; pg8::StaticOrder S; S.init(MP, N, (int)gridDim.x, (int)blockIdx.x);
    pg8::gemm_phase<Epi, pg8::StaticOrder, false>((PG8_LAS unsigned char*)lds, g, S, E, nullptr);
}


#ifndef SMALL_REP
#define SMALL_REP 1
#endif
template <int MODE>
__device__ __forceinline__ void small_gemm(const Params& p, unsigned char* lds, const bf16_t* __restrict__ A, const bf16_t* __restrict__ Bt, int K, int nct, const ssq_t* SS, bf16_t* HB, const float* Rf, ssq_t* SSo) {
    const int tid = ltid(), wid = tid >> 6, lane = tid & 63, fr = lane & 15, G = lane >> 4, wr = wid >> 1, wc = wid & 1;
    bf16_t* PROJ = (bf16_t*)(p.ws + WS_PROJ);
    unsigned char* As = lds; unsigned char* Bs = lds + 65536;
    const int nchunk = (K + 511) >> 9;
    for (int rr = 0; rr < ((MODE == 1) ? 1 : SMALL_REP); ++rr)
    for (int u = blockIdx.x; u < 64 * ((nct + 7) >> 3); u += gridDim.x) {
        const int rt = (u >> 3) & 7, ct = (u & 7) + 8 * (u >> 6);
        if (ct >= nct) continue;
        const int srow = tid >> 6, sgran = tid & 63;
        const bf16_t* ag = A + (size_t)(MP + rt * 64 + srow) * K + sgran * 8;
        size_t bgo[8];
#pragma unroll
        for (int j2 = 0; j2 < 8; ++j2) { const int i = srow + 8 * j2; int brow;
            if (MODE == 2) { const int hc = ct * 32 + (i >> 5) * 16 + (i & 15); brow = 256 * (hc >> 7) + (hc & 127) + 128 * ((i >> 4) & 1); } else brow = ct * 64 + i;
            bgo[j2] = (size_t)brow * K + sgran * 8; }
        u32x4 ra[8], rb[8];
#define SG_LOAD(kc) do { const bool okk = (kc) + sgran * 8 < K; _Pragma("unroll") for (int j2 = 0; j2 < 8; ++j2) { if (okk) { ra[j2] = *(const u32x4*)(ag + (size_t)(8 * j2) * K + (kc)); rb[j2] = *(const u32x4*)(Bt + bgo[j2] + (kc)); } } } while (0)
        SG_LOAD(0);
        f32x4 acc0 = (f32x4){0.f, 0.f, 0.f, 0.f}, acc1 = (f32x4){0.f, 0.f, 0.f, 0.f};
        for (int c = 0; c < nchunk; ++c) {
            const int kc = c << 9;
#pragma unroll
            for (int j2 = 0; j2 < 8; ++j2) { const int row = srow + 8 * j2; const int off = row * 1024 + ((sgran ^ (row & 7)) << 4); *(u32x4*)(As + off) = ra[j2]; *(u32x4*)(Bs + off) = rb[j2]; }
            __syncthreads();
            if (c + 1 < nchunk) SG_LOAD(kc + 512);
            const int nks = (K - kc >= 512) ? 16 : ((K - kc) >> 5);
            const int arow = wr * 16 + fr, brow0 = wc * 32 + fr, brow1 = brow0 + 16;
            for (int ks = 0; ks < nks; ++ks) { const int gran = ks * 4 + G;
                const bf16x8 av = *(const bf16x8*)(As + arow * 1024 + ((gran ^ (arow & 7)) << 4));
                const bf16x8 w0 = *(const bf16x8*)(Bs + brow0 * 1024 + ((gran ^ (brow0 & 7)) << 4)), w1 = *(const bf16x8*)(Bs + brow1 * 1024 + ((gran ^ (brow1 & 7)) << 4));
                acc0 = MFMA16(w0, av, acc0); acc1 = MFMA16(w1, av, acc1); }
            __syncthreads();
        }
#undef SG_LOAD
        const int row = rt * 64 + wr * 16 + fr;
        const size_t grow = (size_t)MP + row;
        if (MODE == 0) { const float rs = rstd_of(SS, (int)grow);
#pragma unroll
            for (int nt = 0; nt < 2; ++nt) { const int col = ct * 64 + wc * 32 + nt * 16 + 4 * G; f32x4 v = (nt ? acc1 : acc0) * rs;
                if (col >= 1536) { const f32x2 a = pg8::gelu_pk((f32x2){v[0], v[1]}), b = pg8::gelu_pk((f32x2){v[2], v[3]}); v = (f32x4){a.x, a.y, b.x, b.y}; }
                *(u32x2*)(PROJ + grow * NAB + col) = (u32x2){pk2(v[0], v[1]), pk2(v[2], v[3])}; }
        } else if (MODE == 1) { float ss = 0.f;
#pragma unroll
            for (int nt = 0; nt < 2; ++nt) { const int col = ct * 64 + wc * 32 + nt * 16 + 4 * G; f32x4 v = nt ? acc1 : acc0;
                if (Rf) v += *(const f32x4*)(Rf + (size_t)row * DM + col);
                else { const u32x2 hv = *(const u32x2*)(HB + grow * DM + col); v += (f32x4){bflo(hv[0]), bfhi(hv[0]), bflo(hv[1]), bfhi(hv[1])}; }
                ss += v[0] * v[0] + v[1] * v[1] + v[2] * v[2] + v[3] * v[3];
                *(u32x2*)(HB + grow * DM + col) = (u32x2){pk2(v[0], v[1]), pk2(v[2], v[3])}; }
            ss += __shfl_xor(ss, 16); ss += __shfl_xor(ss, 32);
            if (G == 0) atomicAdd(SSo + grow, ssq_fix(ss));
        } else if (MODE == 2) { const float rs = rstd_of(SS, (int)grow);
            const int col = ct * 32 + wc * 16 + 4 * G; const f32x4 g = acc0 * rs, uu = acc1 * rs;
            *(u32x2*)(PROJ + grow * FH + col) = (u32x2){pk2(silu_f(g[0]) * uu[0], silu_f(g[1]) * uu[1]), pk2(silu_f(g[2]) * uu[2], silu_f(g[3]) * uu[3])};
        } else { const float rs = rstd_of(SS, (int)grow);
#pragma unroll
            for (int nt = 0; nt < 2; ++nt) { const int col = ct * 64 + wc * 32 + nt * 16 + 4 * G; const f32x4 v = (nt ? acc1 : acc0) * rs;
                if (col >= NCD) { if (col < NCD + 8) *(f32x4*)((float*)(p.ws + WS_DT) + grow * 8 + (col - NCD)) = v; continue; }
                *(u32x2*)(PROJ + grow * NCD + col) = (u32x2){pk2(v[0], v[1]), pk2(v[2], v[3])};
                if (col >= 512 && col < 1536) { const bool isv = col >= 1024; *(f32x4*)(p.out + (isv ? O_VC_S : O_KC_S) + (size_t)row * 512 + (col - (isv ? 1024 : 512))) = v; }
                if (col >= 2048) { const int sb = row >> 6, t = row & 63; if (t >= 61) *(f32x4*)(p.out + O_CONVD_S + ((size_t)sb * 3 + (t - 61)) * 1024 + (col - 2048)) = v; } }
        }
    }
}

struct WtJob { const float* src; const float* gk; bf16_t* dst; int ld, col0, k0, drow0, Kd; };
__device__ __forceinline__ WtJob wt_decode(const Params& p, int t) {
    WtJob J; int q = t;
    if (q < 640) { const int nt = q >> 4, kt = q & 15; J = WtJob{p.w_in_ab, p.norm_mix, (bf16_t*)(p.ws + WS_WT_INAB), NAB, nt * 64, kt * 64, nt * 64, DM}; return J; } q -= 640;
    if (q < 256) { const int nt = q >> 4, kt = q & 15; J = WtJob{p.w_out_ab, nullptr, (bf16_t*)(p.ws + WS_WT_OUTAB), DM, nt * 64, kt * 64, nt * 64, DM}; return J; } q -= 256;
    if (q < 768) { const int nt = q >> 4, kt = q & 15; J = WtJob{p.w_in_cd, p.norm_mix + DM, (bf16_t*)(p.ws + WS_WT_INCD), NCDF, nt * 64, kt * 64, nt * 64, DM}; return J; } q -= 768;
    if (q < 256) { const int nt = q >> 4, kt = q & 15; J = WtJob{p.w_out_cd, nullptr, (bf16_t*)(p.ws + WS_WT_OUTCD), DM, nt * 64, kt * 64, nt * 64, DM}; return J; } q -= 256;
    if (q < 2816) { const int layer = q / 1408; q -= layer * 1408; const int nt = q >> 4, kt = q & 15, pn = nt >> 2, bj = (nt & 3) >> 1, i0 = (nt & 1) * 64;
        J = WtJob{(bj ? p.w_up : p.w_gate) + (size_t)layer * DM * FH, p.norm_ffn + layer * DM, (bf16_t*)(p.ws + WS_WT_GU) + (size_t)layer * 2 * FH * DM, FH, 128 * pn + i0, kt * 64, nt * 64, DM}; return J; } q -= 2816;
    { const int layer = q / 704; q -= layer * 704; const int nt = q / 44, kt = q - nt * 44;
        J = WtJob{p.w_down + (size_t)layer * FH * DM, nullptr, (bf16_t*)(p.ws + WS_WT_DN) + (size_t)layer * DM * FH, DM, nt * 64, kt * 64, nt * 64, FH}; }
    return J;
}
__device__ __forceinline__ void wt_load(const WtJob& J, int tid, float4 (&v)[2], float (&gs)[2]) {
#pragma unroll
    for (int i = 0; i < 2; ++i) { const int k = (tid >> 4) + 32 * i, n4 = (tid & 15) * 4;
        v[i] = *(const float4*)(J.src + (size_t)(J.k0 + k) * J.ld + J.col0 + n4); gs[i] = J.gk ? J.gk[J.k0 + k] : 1.f; }
}
__device__ __forceinline__ void phase_prep(const Params& p, unsigned char* lds) {
    float* tl = (float*)lds; const int tid = ltid();
    { int t = blockIdx.x; WtJob J = wt_decode(p, t < 6144 ? t : 0); float4 v[2]; float gs[2]; wt_load(J, tid, v, gs);
      for (; t < 6144; t += gridDim.x) {
#pragma unroll
          for (int i = 0; i < 2; ++i) { const int k = (tid >> 4) + 32 * i, n4 = (tid & 15) * 4;
              tl[k * 65 + n4] = v[i].x * gs[i]; tl[k * 65 + n4 + 1] = v[i].y * gs[i]; tl[k * 65 + n4 + 2] = v[i].z * gs[i]; tl[k * 65 + n4 + 3] = v[i].w * gs[i]; }
          __syncthreads();
          const int tn = t + (int)gridDim.x; const WtJob Jn = wt_decode(p, tn < 6144 ? tn : t);
          wt_load(Jn, tid, v, gs);
          { const int n = tid >> 3, k8 = (tid & 7) * 8; float f[8];
#pragma unroll
            for (int i = 0; i < 8; ++i) f[i] = tl[(k8 + i) * 65 + n];
            *(u32x4*)(J.dst + (size_t)(J.drow0 + n) * J.Kd + J.k0 + k8) = PACK8(f); }
          __syncthreads();
          J = Jn; } }
    { bf16_t* W = (bf16_t*)(p.ws + WS_WT_INCD);
      for (int i = blockIdx.x * 512 + ltid(); i < 256 * DM; i += gridDim.x * 512) { const int n = i >> 10, k = i & 1023;
          W[(size_t)(NCD + n) * DM + k] = n < 8 ? f2bf(p.w_in_cd[(size_t)k * NCDF + NCD + n] * p.norm_mix[DM + k]) : (bf16_t)0; } }
    { ssq_t* SS = (ssq_t*)(p.ws + WS_SS); for (int i = blockIdx.x * 512 + ltid(); i < 4 * MT; i += gridDim.x * 512) SS[MT + i] = 0ull; }
    { bf16_t* HD = (bf16_t*)(p.ws + WS_HD); for (int i = blockIdx.x * 512 + ltid(); i < 25 * 1024; i += gridDim.x * 512) HD[i] = i < 24 * 1024 ? f2bf(p.state_conv_d[i]) : (bf16_t)0; }
    { bf16_t* WB = (bf16_t*)(p.ws + WS_WSB); for (int i = blockIdx.x * 512 + ltid(); i < 4 * 128 * 128; i += gridDim.x * 512) { const int t = (i >> 7) & 127, sc = i & 127; WB[i] = sc <= t ? f2bf(p.w_s_b[i]) : (bf16_t)0; } }
    { const size_t n8 = (size_t)8 * 512 * 512 / 8; bf16_t* CK = (bf16_t*)(p.ws + WS_CK); bf16_t* CV = (bf16_t*)(p.ws + WS_CV);
      for (size_t i = (size_t)blockIdx.x * 512 + ltid(); i < 2 * n8; i += (size_t)gridDim.x * 512) {
          const bool isv = i >= n8; const size_t e = (isv ? i - n8 : i) * 8; const float* s = (isv ? p.cache_v : p.cache_k) + e;
          const float4 a = *(const float4*)s, b = *(const float4*)(s + 4);
          *(u32x4*)((isv ? CV : CK) + e) = (u32x4){pk2(a.x, a.y), pk2(a.z, a.w), pk2(b.x, b.y), pk2(b.z, b.w)}; } }
}

__device__ __forceinline__ void phase_convert_x(const Params& p) {
    const int tid = ltid(), wid = tid >> 6, lane = tid & 63;
    bf16_t* HB = (bf16_t*)(p.ws + WS_XN); ssq_t* SS = (ssq_t*)(p.ws + WS_SS);
    const int stride = gridDim.x * 8;
    for (int row = blockIdx.x * 8 + wid; row < MT; row += 2 * stride) {
        const int row2 = row + stride; const bool has2 = row2 < MT; const int r2 = has2 ? row2 : row;
        const float* s1 = row < MP ? p.x_prompt + (size_t)row * DM : p.x_sample + (size_t)(row - MP) * DM;
        const float* s2 = r2 < MP ? p.x_prompt + (size_t)r2 * DM : p.x_sample + (size_t)(r2 - MP) * DM;
        float4 v1[4], v2[4];
#pragma unroll
        for (int i = 0; i < 4; ++i) { v1[i] = *(const float4*)(s1 + i * 256 + lane * 4); v2[i] = *(const float4*)(s2 + i * 256 + lane * 4); }
        float ss1 = 0.f, ss2 = 0.f;
#pragma unroll
        for (int i = 0; i < 4; ++i) { ss1 += v1[i].x * v1[i].x + v1[i].y * v1[i].y + v1[i].z * v1[i].z + v1[i].w * v1[i].w; ss2 += v2[i].x * v2[i].x + v2[i].y * v2[i].y + v2[i].z * v2[i].z + v2[i].w * v2[i].w;
            *(u32x2*)(HB + (size_t)row * DM + i * 256 + lane * 4) = (u32x2){pk2(v1[i].x, v1[i].y), pk2(v1[i].z, v1[i].w)};
            if (has2) *(u32x2*)(HB + (size_t)row2 * DM + i * 256 + lane * 4) = (u32x2){pk2(v2[i].x, v2[i].y), pk2(v2[i].z, v2[i].w)}; }
        ss1 = wave_sum(ss1); ss2 = wave_sum(ss2);
        if (lane == 0) { SS[row] = ssq_fix(ss1); if (has2) SS[row2] = ssq_fix(ss2); }
    }
}
__device__ __forceinline__ void phase_final_norm(const Params& p) {
    const int tid = ltid(), wid = tid >> 6, lane = tid & 63;
    const bf16_t* HB = (const bf16_t*)(p.ws + WS_XN); const ssq_t* SS = (const ssq_t*)(p.ws + WS_SS) + (size_t)4 * MT;
    float4 gv[4];
#pragma unroll
    for (int i = 0; i < 4; ++i) gv[i] = *(const float4*)(p.norm_final + i * 256 + lane * 4);
    for (int row = blockIdx.x * 8 + wid; row < MT; row += gridDim.x * 8) {
        const float rstd = rstd_of(SS, row); float* o = p.out + (size_t)row * DM;
#pragma unroll
        for (int i = 0; i < 4; ++i) { const u32x2 hv = *(const u32x2*)(HB + (size_t)row * DM + i * 256 + lane * 4);
            *(float4*)(o + i * 256 + lane * 4) = make_float4(bflo(hv[0]) * rstd * gv[i].x, bfhi(hv[0]) * rstd * gv[i].y, bflo(hv[1]) * rstd * gv[i].z, bfhi(hv[1]) * rstd * gv[i].w); }
    }
}

__device__ __forceinline__ void phase_mixer_ab(const Params& p, unsigned char* lds) {
    const int tid = ltid(), wid = tid >> 6, lane = tid & 63, fr = lane & 15, G = lane >> 4;
    const bf16_t* PROJ = (const bf16_t*)(p.ws + WS_PROJ); bf16_t* MIX = (bf16_t*)(p.ws + WS_MIX);
    bf16_t* VT = (bf16_t*)lds;
    const bf16_t* WSB = (const bf16_t*)(p.ws + WS_WSB);
    for (int u = blockIdx.x; u < 520; u += gridDim.x) {
        const bool smp = u >= 512; const int b = smp ? u - 512 : (u >> 5), blk = smp ? 0 : (u & 31);
        const int L = smp ? 64 : 128, rpw = L >> 3, t0 = wid * rpw;
        const size_t row0 = smp ? (size_t)MP + (size_t)b * 64 : (size_t)b * 4096 + (size_t)blk * 128;
        u32x4 vv8n[8];
#pragma unroll
        for (int i = 0; i < 8; ++i) vv8n[i] = *(const u32x4*)(PROJ + (row0 + t0 + i) * NAB + 2048 + lane * 8);
        { const int c8 = lane * 8; float w0[8], w1[8], w2[8], um2[8], um1[8];
          { const float4 a0 = *(const float4*)(p.conv_w_a + c8), a1 = *(const float4*)(p.conv_w_a + c8 + 4), b0 = *(const float4*)(p.conv_w_a + 512 + c8), b1 = *(const float4*)(p.conv_w_a + 512 + c8 + 4),
                c0 = *(const float4*)(p.conv_w_a + 1024 + c8), c1 = *(const float4*)(p.conv_w_a + 1024 + c8 + 4);
            w0[0] = a0.x; w0[1] = a0.y; w0[2] = a0.z; w0[3] = a0.w; w0[4] = a1.x; w0[5] = a1.y; w0[6] = a1.z; w0[7] = a1.w;
            w1[0] = b0.x; w1[1] = b0.y; w1[2] = b0.z; w1[3] = b0.w; w1[4] = b1.x; w1[5] = b1.y; w1[6] = b1.z; w1[7] = b1.w;
            w2[0] = c0.x; w2[1] = c0.y; w2[2] = c0.z; w2[3] = c0.w; w2[4] = c1.x; w2[5] = c1.y; w2[6] = c1.z; w2[7] = c1.w; }
          const int tg = blk * 128 + t0;
          if (tg > 0) {
              const bf16_t* p2 = PROJ + (row0 + t0 - 2) * NAB; const bf16_t* p1 = PROJ + (row0 + t0 - 1) * NAB;
              const u32x4 xa2 = *(const u32x4*)(p2 + c8), gc2 = *(const u32x4*)(p2 + 1024 + c8), xa1 = *(const u32x4*)(p1 + c8), gc1 = *(const u32x4*)(p1 + 1024 + c8);
              float fa[8], fb[8]; UNPACK8(xa2, fa); UNPACK8(gc2, fb);
#pragma unroll
              for (int k = 0; k < 8; ++k) um2[k] = fa[k] * fb[k];
              UNPACK8(xa1, fa); UNPACK8(gc1, fb);
#pragma unroll
              for (int k = 0; k < 8; ++k) um1[k] = fa[k] * fb[k];
          } else if (smp) {
              const float* h0 = p.state_conv_a + ((size_t)b * 2) * 512 + c8; const float4 a0 = *(const float4*)h0, a1 = *(const float4*)(h0 + 4), b0 = *(const float4*)(h0 + 512), b1 = *(const float4*)(h0 + 516);
              um2[0] = a0.x; um2[1] = a0.y; um2[2] = a0.z; um2[3] = a0.w; um2[4] = a1.x; um2[5] = a1.y; um2[6] = a1.z; um2[7] = a1.w;
              um1[0] = b0.x; um1[1] = b0.y; um1[2] = b0.z; um1[3] = b0.w; um1[4] = b1.x; um1[5] = b1.y; um1[6] = b1.z; um1[7] = b1.w;
          } else {
#pragma unroll
              for (int k = 0; k < 8; ++k) { um2[k] = 0.f; um1[k] = 0.f; }
          }
#define MXA_LOAD(X, GB, GC, ib) do { _Pragma("unroll") for (int i = 0; i < 4; ++i) { const bf16_t* pr = PROJ + (row0 + t0 + (ib) + i) * NAB; X[i] = *(const u32x4*)(pr + c8); GB[i] = *(const u32x4*)(pr + 512 + c8); GC[i] = *(const u32x4*)(pr + 1024 + c8); } } while (0)
#define MXA_COMP(X, GB, GC, ib) do { _Pragma("unroll") for (int i = 0; i < 4; ++i) { const int t = t0 + (ib) + i; const size_t r = row0 + t; \
                  float fa[8], fb[8], fc[8], U[8], y[8]; UNPACK8(X[i], fa); UNPACK8(GB[i], fb); UNPACK8(GC[i], fc); \
                  _Pragma("unroll") for (int k = 0; k < 8; ++k) { U[k] = fc[k] * fa[k]; y[k] = fb[k] * (w0[k] * um2[k] + w1[k] * um1[k] + w2[k] * U[k]); } \
                  *(u32x4*)(MIX + r * DM + c8) = PACK8(y); \
                  if (t >= L - 2 && (smp || blk == 31)) { float* o = p.out + (smp ? O_CONVA_S : O_CONVA_P) + ((size_t)b * 2 + (t - (L - 2))) * 512 + c8; \
                      *(float4*)o = make_float4(U[0], U[1], U[2], U[3]); *(float4*)(o + 4) = make_float4(U[4], U[5], U[6], U[7]); } \
                  _Pragma("unroll") for (int k = 0; k < 8; ++k) { um2[k] = um1[k]; um1[k] = U[k]; } } } while (0)
          u32x4 xaA[4], gbA[4], gcA[4], xaB[4], gbB[4], gcB[4];
          MXA_LOAD(xaA, gbA, gcA, 0);
          for (int i0 = 0; i0 < rpw; i0 += 8) {
              MXA_LOAD(xaB, gbB, gcB, i0 + 4);
              MXA_COMP(xaA, gbA, gcA, i0);
              { const int ib = i0 + 8 < rpw ? i0 + 8 : i0; MXA_LOAD(xaA, gbA, gcA, ib); }
              MXA_COMP(xaB, gbB, gcB, i0 + 4); }
#undef MXA_LOAD
#undef MXA_COMP
        }
        for (int i0 = 0; i0 < rpw; i0 += 8) {
            u32x4 vv8[8];
#pragma unroll
            for (int i = 0; i < 8; ++i) vv8[i] = vv8n[i];
            { const int ib = i0 + 8 < rpw ? i0 + 8 : i0;
#pragma unroll
              for (int i = 0; i < 8; ++i) vv8n[i] = *(const u32x4*)(PROJ + (row0 + t0 + ib + i) * NAB + 2048 + lane * 8); }
            float g8[8], b8[8], ovp[8]; unsigned pkv[8][4];
            { const float4 a = *(const float4*)(p.ln_g_b + lane * 8), bq = *(const float4*)(p.ln_g_b + lane * 8 + 4), c = *(const float4*)(p.ln_b_b + lane * 8), d = *(const float4*)(p.ln_b_b + lane * 8 + 4);
              g8[0] = a.x; g8[1] = a.y; g8[2] = a.z; g8[3] = a.w; g8[4] = bq.x; g8[5] = bq.y; g8[6] = bq.z; g8[7] = bq.w; b8[0] = c.x; b8[1] = c.y; b8[2] = c.z; b8[3] = c.w; b8[4] = d.x; b8[5] = d.y; b8[6] = d.z; b8[7] = d.w; }
#pragma unroll
            for (int i = 0; i < 8; ++i) { const int t = t0 + i0 + i; const size_t r = row0 + t; float f[8]; UNPACK8(vv8[i], f);
                float sm = 0.f;
#pragma unroll
                for (int k = 0; k < 8; ++k) sm += f[k];
                sm = wave_sum(sm); const float mean = sm * (1.f / 512.f); float q = 0.f;
#pragma unroll
                for (int k = 0; k < 8; ++k) { const float dd = f[k] - mean; q += dd * dd; }
                q = wave_sum(q); const float rstd = rsqrtf(q * (1.f / 512.f) + 1e-5f);
                float o8[8];
#pragma unroll
                for (int k = 0; k < 8; ++k) { o8[k] = (f[k] - mean) * rstd * g8[k] + b8[k]; if (i & 1) pkv[k][i >> 1] = pk2(ovp[k], o8[k]); else ovp[k] = o8[k]; }
                if (smp) { float* o = p.out + O_VB_S + (r - MP) * 512 + lane * 8; *(float4*)o = make_float4(o8[0], o8[1], o8[2], o8[3]); *(float4*)(o + 4) = make_float4(o8[4], o8[5], o8[6], o8[7]); } }
#pragma unroll
            for (int k = 0; k < 8; ++k) { const int c = lane * 8 + k; *(u32x4*)(VT + c * 128 + swzv(c, t0 + i0)) = (u32x4){pkv[k][0], pkv[k][1], pkv[k][2], pkv[k][3]}; } }
        __syncthreads();
        if (wid < (L >> 4)) {
            const int t = 16 * wid + fr; const size_t r = row0 + t; const int nks = (16 * (wid + 1) + 31) >> 5;
            for (int g = 0; g < 4; ++g) {
                f32x4 acc[8];
#pragma unroll
                for (int ct = 0; ct < 8; ++ct) acc[ct] = (f32x4){0.f, 0.f, 0.f, 0.f};
                for (int ks = 0; ks < nks; ++ks) { const bf16x8 bw = *(const bf16x8*)(WSB + ((size_t)g * 128 + t) * 128 + 32 * ks + 8 * G);
#pragma unroll
                    for (int ct = 0; ct < 8; ++ct) { const int c = g * 128 + 16 * ct + fr; const bf16x8 av = *(const bf16x8*)(VT + c * 128 + swzv(c, 32 * ks + 8 * G)); acc[ct] = MFMA16(av, bw, acc[ct]); } }
                const float bs = p.b_s_b[g * 128 + t];
#pragma unroll
                for (int ct = 0; ct < 8; ++ct) { const int c = 16 * ct + 4 * G; const u32x2 uu = *(const u32x2*)(PROJ + r * NAB + 1536 + g * 128 + c);
                    const float y0 = bflo(uu[0]) * (acc[ct][0] + bs), y1 = bfhi(uu[0]) * (acc[ct][1] + bs), y2 = bflo(uu[1]) * (acc[ct][2] + bs), y3 = bfhi(uu[1]) * (acc[ct][3] + bs);
                    *(u32x2*)(MIX + r * DM + 512 + g * 128 + c) = (u32x2){pk2(y0, y1), pk2(y2, y3)}; }
            }
        }
        __syncthreads();
    }
}

constexpr int N_ATT_P = 2048, N_ATT = N_ATT_P + 64;
__device__ __forceinline__ void att_unit(const Params& p, unsigned char* lds, int v) {
    const int tid = ltid(), wid = tid >> 6, lane = tid & 63, fr = lane & 15, G = lane >> 4;
    const bf16_t* PROJ = (const bf16_t*)(p.ws + WS_PROJ); bf16_t* MIX = (bf16_t*)(p.ws + WS_MIX);
    const bf16_t* CK = (const bf16_t*)(p.ws + WS_CK); const bf16_t* CV = (const bf16_t*)(p.ws + WS_CV);
    float* tab = (float*)lds; bf16_t* KSB = (bf16_t*)(lds + 1040);
    const bool smp = v >= N_ATT_P; int b, h, c0, jlo, jhi;
    if (!smp) { b = v >> 7; h = (v >> 4) & 7; c0 = 4 * (v & 15); jlo = c0 - 8 > 0 ? c0 - 8 : 0; jhi = c0 + 3; }
    else { const int sv = v - N_ATT_P; b = sv >> 3; h = sv & 7; c0 = 8; jlo = 0; jhi = 8; }
    const int cq = c0 + (wid >> 1), qh = wid & 1; const bool wact = !smp || wid < 2;
    const size_t qrow0 = (smp ? (size_t)MP + (size_t)b * 64 : (size_t)b * 4096 + (size_t)cq * 64) + qh * 32 + fr;
    for (int i = tid; i < 257; i += 512) tab[i] = p.rel_bias_c[h * 257 + i] * 1.44269504089f;
    const float tb_far = p.rel_bias_c[h * 257 + 256] * 1.44269504089f;
    bf16x8 qf[2][2];
#pragma unroll
    for (int qi = 0; qi < 2; ++qi)
#pragma unroll
        for (int ks = 0; ks < 2; ++ks) qf[qi][ks] = wact ? *(const bf16x8*)(PROJ + (qrow0 + 16 * qi) * NCD + h * 64 + 32 * ks + 8 * G) : (bf16x8){0, 0, 0, 0, 0, 0, 0, 0};
    const int skey = tid >> 3, sd8 = (tid & 7) * 8;
    u32x4 krr[4], vrr[4];
#define ATT_LOAD(j, kr, vr) do { const int jj_ = (j) < jhi ? (j) : jhi; const bool fromP = !smp || jj_ == 8; \
        const size_t rrP = (smp ? (size_t)MP + (size_t)b * 64 : (size_t)b * 4096 + (size_t)jj_ * 64) + skey; const size_t offC = ((size_t)b * 512 + (size_t)(jj_ & 7) * 64 + skey) * 512 + h * 64 + sd8; \
        const bf16_t* kp_ = fromP ? PROJ + rrP * NCD + 512 + h * 64 + sd8 : CK + offC; const bf16_t* vp_ = fromP ? PROJ + rrP * NCD + 1024 + h * 64 + sd8 : CV + offC; \
        kr = *(const u32x4*)kp_; vr = *(const u32x4*)vp_; } while (0)
#pragma unroll
    for (int s_ = 0; s_ < 4; ++s_) ATT_LOAD(jlo + s_, krr[s_], vrr[s_]);
    float m[2] = {-1e30f, -1e30f}, lsum[2] = {0.f, 0.f}; f32x4 O[2][4];
#pragma unroll
    for (int qi = 0; qi < 2; ++qi)
#pragma unroll
        for (int dt = 0; dt < 4; ++dt) O[qi][dt] = (f32x4){0.f, 0.f, 0.f, 0.f};
    for (int jb = jlo; jb <= jhi; jb += 4) {
#pragma unroll
      for (int s_ = 0; s_ < 4; ++s_) { const int j = jb + s_; if (j <= jhi) {
        bf16_t* KS = KSB + s_ * 9216; bf16_t* VTt = KS + 4608;
        if ((s_ & 1) == 0) {
#pragma unroll
            for (int q_ = 0; q_ < 2; ++q_) { bf16_t* KSq = KSB + ((s_ + q_) & 3) * 9216; bf16_t* VTq = KSq + 4608;
                *(u32x4*)(KSq + skey * 72 + sd8) = krr[(s_ + q_) & 3];
#pragma unroll
                for (int k = 0; k < 8; ++k) VTq[(sd8 + k) * 72 + swz8(sd8 + k, skey)] = (unsigned short)((k & 1) ? (vrr[(s_ + q_) & 3][k >> 1] >> 16) : (vrr[(s_ + q_) & 3][k >> 1] & 0xffffu)); }
            __syncthreads();
            ATT_LOAD(j + 4, krr[s_], vrr[s_]); ATT_LOAD(j + 5, krr[(s_ + 1) & 3], vrr[(s_ + 1) & 3]);
        }
        if (wact && j >= cq - 8 && j <= cq) {
            f32x4 s[2][4];
#pragma unroll
            for (int kt = 0; kt < 4; ++kt) { s[0][kt] = (f32x4){0.f, 0.f, 0.f, 0.f}; s[1][kt] = (f32x4){0.f, 0.f, 0.f, 0.f};
#pragma unroll
                for (int ks = 0; ks < 2; ++ks) { const bf16x8 a = *(const bf16x8*)(KS + (16 * kt + fr) * 72 + 32 * ks + 8 * G); s[0][kt] = MFMA16(a, qf[0][ks], s[0][kt]); s[1][kt] = MFMA16(a, qf[1][ks], s[1][kt]); } }
            bf16x8 pb[2][2];
#pragma unroll
            for (int qi = 0; qi < 2; ++qi) {
                const int rel0 = (cq * 64 + qh * 32 + qi * 16 + fr) - (j * 64 + 4 * G);
                float mx = -1e30f;
                if (cq - j >= 3) {
#pragma unroll
                    for (int kt = 0; kt < 4; ++kt)
#pragma unroll
                        for (int r = 0; r < 4; ++r) { const float sv = s[qi][kt][r] * (0.125f * 1.44269504089f) + tb_far; s[qi][kt][r] = sv; mx = fmaxf(mx, sv); }
                } else {
#pragma unroll
                    for (int kt = 0; kt < 4; ++kt)
#pragma unroll
                        for (int r = 0; r < 4; ++r) { int rel = rel0 - 16 * kt - r; rel = rel < -128 ? -128 : (rel > 128 ? 128 : rel); const float sv = s[qi][kt][r] * (0.125f * 1.44269504089f) + tab[rel + 128]; s[qi][kt][r] = sv; mx = fmaxf(mx, sv); }
                }
                mx = fmaxf(mx, __shfl_xor(mx, 16)); mx = fmaxf(mx, __shfl_xor(mx, 32));
                const float mnew = fmaxf(m[qi], mx), alpha = __builtin_amdgcn_exp2f(m[qi] - mnew); m[qi] = mnew;
                float ps = 0.f;
#pragma unroll
                for (int kt = 0; kt < 4; ++kt)
#pragma unroll
                    for (int r = 0; r < 4; ++r) { const float e = __builtin_amdgcn_exp2f(s[qi][kt][r] - mnew); s[qi][kt][r] = e; ps += e; }
                lsum[qi] = lsum[qi] * alpha + ps;
#pragma unroll
                for (int dt = 0; dt < 4; ++dt) O[qi][dt] = O[qi][dt] * alpha;
#pragma unroll
                for (int kk = 0; kk < 2; ++kk)
                    pb[qi][kk] = as_bf16x8((u32x4){pk2(s[qi][2 * kk][0], s[qi][2 * kk][1]), pk2(s[qi][2 * kk][2], s[qi][2 * kk][3]), pk2(s[qi][2 * kk + 1][0], s[qi][2 * kk + 1][1]), pk2(s[qi][2 * kk + 1][2], s[qi][2 * kk + 1][3])});
            }
#pragma unroll
            for (int kk = 0; kk < 2; ++kk)
#pragma unroll
                for (int dt = 0; dt < 4; ++dt) { const bf16_t* vrow = VTt + (16 * dt + fr) * 72; const u32x2 v0 = *(const u32x2*)(vrow + swz8(16 * dt + fr, 32 * kk + 4 * G)), v1 = *(const u32x2*)(vrow + swz8(16 * dt + fr, 32 * kk + 16 + 4 * G));
                    const bf16x8 av = as_bf16x8((u32x4){v0[0], v0[1], v1[0], v1[1]});
                    O[0][dt] = MFMA16(av, pb[0][kk], O[0][dt]); O[1][dt] = MFMA16(av, pb[1][kk], O[1][dt]); }
        }
      } }
    }
#undef ATT_LOAD
    if (wact) {
#pragma unroll
        for (int qi = 0; qi < 2; ++qi) { float ls = lsum[qi]; ls += __shfl_xor(ls, 16); ls += __shfl_xor(ls, 32); const float inv = 1.f / ls;
#pragma unroll
            for (int dt = 0; dt < 4; ++dt) *(u32x2*)(MIX + (qrow0 + 16 * qi) * DM + h * 64 + 16 * dt + 4 * G) = (u32x2){pk2(O[qi][dt][0] * inv, O[qi][dt][1] * inv), pk2(O[qi][dt][2] * inv, O[qi][dt][3] * inv)}; }
    }
    __syncthreads();
}

constexpr int N_SSD = 2 * 1032;
constexpr int SL_DT = 0, SL_CUM = 1024, SL_XT = 2048, SL_BN = SL_XT + 4 * 64 * 72 * 2, SL_CN = SL_BN + 64 * 136 * 2, SL_BT = SL_CN + 64 * 136 * 2, SL_CB = SL_BT + 128 * 72 * 2, SL_SS = SL_CB + 64 * 68 * 4, SL_END = SL_SS + 1024;
static_assert(SL_END <= LDS_BYTES, "LDS");
struct SsdUnit { bool smp; int b, c, g, cs; size_t row0; };
__device__ __forceinline__ SsdUnit ssd_decode(int u) { SsdUnit s; s.g = u & 1; const int cs = u >> 1; s.cs = cs; s.smp = cs >= 1024;
    if (s.smp) { s.b = cs - 1024; s.c = 0; s.row0 = (size_t)MP + (size_t)s.b * 64; } else { s.b = cs >> 6; s.c = cs & 63; s.row0 = (size_t)cs * 64; } return s; }

__device__ __forceinline__ void ssd_rows_load(const Params& p, const SsdUnit& U, u32x4 (&rws)[11]) {
    const int tid = ltid(), wid = tid >> 6, lane = tid & 63; const int g = U.g;
    const bf16_t* PROJ = (const bf16_t*)(p.ws + WS_PROJ); const bf16_t* HD = (const bf16_t*)(p.ws + WS_HD);
    const int xc = lane < 32 ? g * 256 + lane * 8 : (lane < 48 ? 512 + g * 128 + (lane - 32) * 8 : 768 + g * 128 + (lane - 48) * 8);
    const int t0 = wid * 8;
#pragma unroll
    for (int k = 0; k < 11; ++k) { const int tt = t0 - 3 + k; const bool inseq = tt >= 0 || (!U.smp && U.c > 0);
        const bf16_t* src = inseq ? PROJ + (size_t)((long)U.row0 + tt) * NCD + 2048 + xc : (U.smp ? HD + (size_t)(U.b * 3 + (tt < 0 ? 3 + tt : 0)) * 1024 + xc : HD + 24 * 1024 + xc);
        rws[k] = *(const u32x4*)src; }
}
template <bool OUTP>
__device__ __forceinline__ void ssd_stage(const Params& p, unsigned char* lds, const SsdUnit& U, const u32x4 (&rws)[11]) {
    const int tid = ltid(), wid = tid >> 6, lane = tid & 63;
    const bf16_t* PROJ = (const bf16_t*)(p.ws + WS_PROJ); const float* DT = (const float*)(p.ws + WS_DT);
    bf16_t* XT = (bf16_t*)(lds + SL_XT); bf16_t* BN = (bf16_t*)(lds + SL_BN); bf16_t* CN = (bf16_t*)(lds + SL_CN); bf16_t* BT = (bf16_t*)(lds + SL_BT);
    float* dtl = (float*)(lds + SL_DT); float* cuml = (float*)(lds + SL_CUM);
    const int g = U.g;
    const int xc = lane < 32 ? g * 256 + lane * 8 : (lane < 48 ? 512 + g * 128 + (lane - 32) * 8 : 768 + g * 128 + (lane - 48) * 8);
    const bool act = OUTP || lane < 48;
    if (act) {
        float cw[4][8], cb[8], win[3][8];
        const int t0 = wid * 8;
#pragma unroll
        for (int k = 0; k < 4; ++k) { const float4 a = *(const float4*)(p.conv_w_d + k * 1024 + xc), bb = *(const float4*)(p.conv_w_d + k * 1024 + xc + 4);
            cw[k][0] = a.x; cw[k][1] = a.y; cw[k][2] = a.z; cw[k][3] = a.w; cw[k][4] = bb.x; cw[k][5] = bb.y; cw[k][6] = bb.z; cw[k][7] = bb.w; }
        { const float4 a = *(const float4*)(p.conv_b_d + xc), bb = *(const float4*)(p.conv_b_d + xc + 4); cb[0] = a.x; cb[1] = a.y; cb[2] = a.z; cb[3] = a.w; cb[4] = bb.x; cb[5] = bb.y; cb[6] = bb.z; cb[7] = bb.w; }
#pragma unroll
        for (int k = 0; k < 3; ++k) UNPACK8(rws[k], win[k]);
        unsigned pkt[8][4]; float oprev[8];
#pragma unroll
        for (int i = 0; i < 8; ++i) { const int t = t0 + i; float cur[8], o[8]; UNPACK8(rws[3 + i], cur);
#pragma unroll
            for (int e = 0; e < 8; ++e) { o[e] = silu_f(cw[0][e] * win[0][e] + cw[1][e] * win[1][e] + cw[2][e] * win[2][e] + cw[3][e] * cur[e] + cb[e]); win[0][e] = win[1][e]; win[1][e] = win[2][e]; win[2][e] = cur[e]; }
            if (OUTP && lane >= 32) { if (lane < 48) *(u32x4*)(BN + t * 136 + (lane - 32) * 8) = PACK8(o); else *(u32x4*)(CN + t * 136 + (lane - 48) * 8) = PACK8(o); }
#pragma unroll
            for (int e = 0; e < 8; ++e) { if (i & 1) pkt[e][i >> 1] = pk2(oprev[e], o[e]); else oprev[e] = o[e]; } }
        if (lane < 32) { const int hh = lane >> 3, pp = (lane & 7) * 8;
#pragma unroll
            for (int e = 0; e < 8; ++e) *(u32x4*)(XT + (hh * 64 + pp + e) * 72 + swz8(pp + e, t0)) = (u32x4){pkt[e][0], pkt[e][1], pkt[e][2], pkt[e][3]}; }
        else if (!OUTP && lane < 48) { const int n = (lane - 32) * 8;
#pragma unroll
            for (int e = 0; e < 8; ++e) *(u32x4*)(BT + (n + e) * 72 + swz8(n + e, t0)) = (u32x4){pkt[e][0], pkt[e][1], pkt[e][2], pkt[e][3]}; }
    }
    if (wid < 4) { const int h = g * 4 + wid; const float x = DT[(U.row0 + lane) * 8 + h] + p.dt_bias_d[h];
        const float dt = fmaxf(x, 0.f) + log1pf(expf(-fabsf(x))); const float A = -expf(p.a_log_d[h]); float a = dt * A;
#pragma unroll
        for (int o = 1; o < 64; o <<= 1) { const float y = __shfl_up(a, o); if (lane >= o) a += y; }
        dtl[wid * 64 + lane] = dt; cuml[wid * 64 + lane] = a; }
}

__device__ __forceinline__ void ssd_state_unit(const Params& p, unsigned char* lds, int u, int unext, u32x4 (&rws)[11]) {
    const int tid = ltid(), wid = tid >> 6, lane = tid & 63, fr = lane & 15, G = lane >> 4;
    const SsdUnit U = ssd_decode(u);
    ssd_stage<false>(p, lds, U, rws);
    ssd_rows_load(p, ssd_decode(unext), rws);
    __syncthreads();
    const bf16_t* XT = (const bf16_t*)(lds + SL_XT); const bf16_t* BT = (const bf16_t*)(lds + SL_BT);
    const float* dtl = (const float*)(lds + SL_DT); const float* cuml = (const float*)(lds + SL_CUM);
    unsigned short* SB = (unsigned short*)(p.ws + WS_SBUF); float* DEC = (float*)(p.ws + WS_DEC);
    const int hh = wid >> 1, half = wid & 1, h = U.g * 4 + hh; const float cumQ = cuml[hh * 64 + 63];
    f32x4 acc[2][8];
#pragma unroll
    for (int pt = 0; pt < 2; ++pt)
#pragma unroll
        for (int nt = 0; nt < 8; ++nt) acc[pt][nt] = (f32x4){0.f, 0.f, 0.f, 0.f};
#pragma unroll
    for (int ks = 0; ks < 2; ++ks) { const int s0 = 32 * ks + 8 * G; float w[8];
        { const float4 d0 = *(const float4*)(dtl + hh * 64 + s0), d1 = *(const float4*)(dtl + hh * 64 + s0 + 4), c0 = *(const float4*)(cuml + hh * 64 + s0), c1 = *(const float4*)(cuml + hh * 64 + s0 + 4);
          w[0] = d0.x * __expf(cumQ - c0.x); w[1] = d0.y * __expf(cumQ - c0.y); w[2] = d0.z * __expf(cumQ - c0.z); w[3] = d0.w * __expf(cumQ - c0.w);
          w[4] = d1.x * __expf(cumQ - c1.x); w[5] = d1.y * __expf(cumQ - c1.y); w[6] = d1.z * __expf(cumQ - c1.z); w[7] = d1.w * __expf(cumQ - c1.w); }
        bf16x8 xb[2];
#pragma unroll
        for (int pt = 0; pt < 2; ++pt) { const u32x4 raw = *(const u32x4*)(XT + (hh * 64 + 32 * half + 16 * pt + fr) * 72 + swz8(32 * half + 16 * pt + fr, s0)); float f[8]; UNPACK8(raw, f);
#pragma unroll
            for (int e = 0; e < 8; ++e) f[e] *= w[e];
            xb[pt] = as_bf16x8(PACK8(f)); }
#pragma unroll
        for (int nt = 0; nt < 8; ++nt) { const bf16x8 a = *(const bf16x8*)(BT + (16 * nt + fr) * 72 + swz8(16 * nt + fr, s0));
#pragma unroll
            for (int pt = 0; pt < 2; ++pt) acc[pt][nt] = MFMA16(a, xb[pt], acc[pt][nt]); } }
#pragma unroll
    for (int pt = 0; pt < 2; ++pt)
#pragma unroll
        for (int nt = 0; nt < 8; ++nt) { const int pp = 32 * half + 16 * pt + fr, n = 16 * nt + 4 * G; *(u32x2*)(SB + (((size_t)U.cs * 8 + h) * 64 + pp) * 128 + n) = (u32x2){pkh2(acc[pt][nt][0], acc[pt][nt][1]), pkh2(acc[pt][nt][2], acc[pt][nt][3])}; }
    if (half == 0 && lane == 0) DEC[U.cs * 8 + h] = expf(cumQ);
    __syncthreads();
}

__device__ __forceinline__ void phase_scan(const Params& p) {
    const unsigned short* SB = (const unsigned short*)(p.ws + WS_SBUF); const float* DEC = (const float*)(p.ws + WS_DEC); bf16_t* HIN = (bf16_t*)p.out;
    for (int e = blockIdx.x * 512 + ltid(); e < 131072 + 65536; e += gridDim.x * 512) {
        if (e < 131072) { const int bb = e >> 13, off = (e & 8191) * 8, h = off >> 13; float hs[8];
#pragma unroll
            for (int k = 0; k < 8; ++k) hs[k] = 0.f;
            for (int c0 = 0; c0 < 64; c0 += 8) { u32x4 sv[8]; float d[8];
#pragma unroll
                for (int i = 0; i < 8; ++i) { const size_t cs = (size_t)bb * 64 + c0 + i; sv[i] = *(const u32x4*)(SB + cs * 65536 + off); d[i] = DEC[cs * 8 + h]; }
#pragma unroll
                for (int i = 0; i < 8; ++i) { const size_t cs = (size_t)bb * 64 + c0 + i; *(u32x4*)(HIN + cs * 65536 + off) = PACK8(hs);
                    hs[0] = d[i] * hs[0] + h16lo(sv[i][0]); hs[1] = d[i] * hs[1] + h16hi(sv[i][0]); hs[2] = d[i] * hs[2] + h16lo(sv[i][1]); hs[3] = d[i] * hs[3] + h16hi(sv[i][1]);
                    hs[4] = d[i] * hs[4] + h16lo(sv[i][2]); hs[5] = d[i] * hs[5] + h16hi(sv[i][2]); hs[6] = d[i] * hs[6] + h16lo(sv[i][3]); hs[7] = d[i] * hs[7] + h16hi(sv[i][3]); } }
            float* o = p.out + O_SSM_P + (size_t)bb * 65536 + off; *(float4*)o = make_float4(hs[0], hs[1], hs[2], hs[3]); *(float4*)(o + 4) = make_float4(hs[4], hs[5], hs[6], hs[7]);
        } else { const int e2 = e - 131072, sb_ = e2 >> 13, off = (e2 & 8191) * 8, h = off >> 13; const size_t cs = 1024 + sb_;
            const float* h0 = p.state_ssm_d + (size_t)sb_ * 65536 + off; const float4 a = *(const float4*)h0, b = *(const float4*)(h0 + 4);
            float hs[8] = {a.x, a.y, a.z, a.w, b.x, b.y, b.z, b.w};
            const u32x4 sv = *(const u32x4*)(SB + cs * 65536 + off); const float d = DEC[cs * 8 + h];
            const float4 sa = make_float4(h16lo(sv[0]), h16hi(sv[0]), h16lo(sv[1]), h16hi(sv[1])), sb = make_float4(h16lo(sv[2]), h16hi(sv[2]), h16lo(sv[3]), h16hi(sv[3]));
            *(u32x4*)(HIN + cs * 65536 + off) = PACK8(hs);
            float* o = p.out + O_SSM_S + (size_t)sb_ * 65536 + off;
            *(float4*)o = make_float4(d * hs[0] + sa.x, d * hs[1] + sa.y, d * hs[2] + sa.z, d * hs[3] + sa.w); *(float4*)(o + 4) = make_float4(d * hs[4] + sb.x, d * hs[5] + sb.y, d * hs[6] + sb.z, d * hs[7] + sb.w); }
    }
}

template <bool PIPE>
__device__ __forceinline__ void ssd_out_unit(const Params& p, unsigned char* lds, int u, int unext, u32x4 (&rws)[11]) {
    const int tid = ltid(), wid = tid >> 6, lane = tid & 63, fr = lane & 15, G = lane >> 4;
    const SsdUnit U = ssd_decode(u);
    if (!PIPE) ssd_rows_load(p, U, rws);
    ssd_stage<true>(p, lds, U, rws);
    if (PIPE) ssd_rows_load(p, ssd_decode(unext), rws);
    bf16x8 hfr[4][4]; u32x2 zpre[2][4];
    { const int hh_ = wid >> 1, half_ = wid & 1, h_ = U.g * 4 + hh_; const bf16_t* hb_ = (const bf16_t*)p.out + ((size_t)U.cs * 8 + h_) * 8192;
#pragma unroll
      for (int ks = 0; ks < 4; ++ks)
#pragma unroll
          for (int pt = 0; pt < 4; ++pt) hfr[ks][pt] = *(const bf16x8*)(hb_ + (16 * pt + fr) * 128 + 32 * ks + 8 * G);
#pragma unroll
      for (int tt2 = 0; tt2 < 2; ++tt2)
#pragma unroll
          for (int pt = 0; pt < 4; ++pt) zpre[tt2][pt] = *(const u32x2*)((const bf16_t*)(p.ws + WS_PROJ) + (U.row0 + 16 * (2 * half_ + tt2) + fr) * NCD + 1536 + h_ * 64 + 16 * pt + 4 * G); }
    __syncthreads();
    const bf16_t* PROJ = (const bf16_t*)(p.ws + WS_PROJ); bf16_t* MIX = (bf16_t*)(p.ws + WS_MIX); const bf16_t* HIN = (const bf16_t*)p.out;
    const bf16_t* XT = (const bf16_t*)(lds + SL_XT); const bf16_t* BN = (const bf16_t*)(lds + SL_BN); const bf16_t* CN = (const bf16_t*)(lds + SL_CN);
    const float* dtl = (const float*)(lds + SL_DT); const float* cuml = (const float*)(lds + SL_CUM); float* CB = (float*)(lds + SL_CB); float* SS = (float*)(lds + SL_SS);
    for (int idx = wid; idx < 10; idx += 8) { const int tt = idx < 1 ? 0 : (idx < 3 ? 1 : (idx < 6 ? 2 : 3)), st = idx - (tt * (tt + 1)) / 2;
        f32x4 acc = (f32x4){0.f, 0.f, 0.f, 0.f};
#pragma unroll
        for (int ks = 0; ks < 4; ++ks) { const bf16x8 a = *(const bf16x8*)(BN + (16 * st + fr) * 136 + 32 * ks + 8 * G), bq = *(const bf16x8*)(CN + (16 * tt + fr) * 136 + 32 * ks + 8 * G); acc = MFMA16(a, bq, acc); }
        *(f32x4*)(CB + (16 * tt + fr) * 68 + 16 * st + 4 * G) = acc; }
    __syncthreads();
    const int hh = wid >> 1, half = wid & 1, h = U.g * 4 + hh;
    f32x4 acc1[2][4], acc2[2][4];
#pragma unroll
    for (int a = 0; a < 2; ++a)
#pragma unroll
        for (int b = 0; b < 4; ++b) { acc1[a][b] = (f32x4){0.f, 0.f, 0.f, 0.f}; acc2[a][b] = (f32x4){0.f, 0.f, 0.f, 0.f}; }
#pragma unroll
    for (int tt2 = 0; tt2 < 2; ++tt2) { const int ttile = 2 * half + tt2, t = 16 * ttile + fr; const float ct = cuml[hh * 64 + t];
#pragma unroll
        for (int ks = 0; ks < 2; ++ks) { if (32 * ks <= 16 * ttile + 15) { const int s0 = 32 * ks + 8 * G;
            const f32x4 cb0 = *(const f32x4*)(CB + t * 68 + s0), cb1 = *(const f32x4*)(CB + t * 68 + s0 + 4);
            const float4 d0 = *(const float4*)(dtl + hh * 64 + s0), d1 = *(const float4*)(dtl + hh * 64 + s0 + 4), c0 = *(const float4*)(cuml + hh * 64 + s0), c1 = *(const float4*)(cuml + hh * 64 + s0 + 4);
            float mm[8];
            mm[0] = (s0 + 0 <= t) ? cb0[0] * __expf(ct - c0.x) * d0.x : 0.f; mm[1] = (s0 + 1 <= t) ? cb0[1] * __expf(ct - c0.y) * d0.y : 0.f;
            mm[2] = (s0 + 2 <= t) ? cb0[2] * __expf(ct - c0.z) * d0.z : 0.f; mm[3] = (s0 + 3 <= t) ? cb0[3] * __expf(ct - c0.w) * d0.w : 0.f;
            mm[4] = (s0 + 4 <= t) ? cb1[0] * __expf(ct - c1.x) * d1.x : 0.f; mm[5] = (s0 + 5 <= t) ? cb1[1] * __expf(ct - c1.y) * d1.y : 0.f;
            mm[6] = (s0 + 6 <= t) ? cb1[2] * __expf(ct - c1.z) * d1.z : 0.f; mm[7] = (s0 + 7 <= t) ? cb1[3] * __expf(ct - c1.w) * d1.w : 0.f;
            const bf16x8 mb = as_bf16x8(PACK8(mm));
#pragma unroll
            for (int pt = 0; pt < 4; ++pt) { const bf16x8 a = *(const bf16x8*)(XT + (hh * 64 + 16 * pt + fr) * 72 + swz8(16 * pt + fr, s0)); acc1[tt2][pt] = MFMA16(a, mb, acc1[tt2][pt]); } } } }
    { const bf16_t* hb = HIN + ((size_t)U.cs * 8 + h) * 8192;
#pragma unroll
      for (int ks = 0; ks < 4; ++ks) { bf16x8 bq[2];
#pragma unroll
          for (int tt2 = 0; tt2 < 2; ++tt2) bq[tt2] = *(const bf16x8*)(CN + (16 * (2 * half + tt2) + fr) * 136 + 32 * ks + 8 * G);
#pragma unroll
          for (int pt = 0; pt < 4; ++pt) { bf16x8 a;
              if (U.smp) { const float* hf = p.state_ssm_d + ((size_t)U.b * 8 + h) * 8192 + (16 * pt + fr) * 128 + 32 * ks + 8 * G; const float4 x0 = *(const float4*)hf, x1 = *(const float4*)(hf + 4);
                  a = as_bf16x8((u32x4){pk2(x0.x, x0.y), pk2(x0.z, x0.w), pk2(x1.x, x1.y), pk2(x1.z, x1.w)}); }
              else a = hfr[ks][pt];
#pragma unroll
              for (int tt2 = 0; tt2 < 2; ++tt2) acc2[tt2][pt] = MFMA16(a, bq[tt2], acc2[tt2][pt]); } } }
    const float dsk = p.d_skip_d[h];
#pragma unroll
    for (int tt2 = 0; tt2 < 2; ++tt2) { const int t = 16 * (2 * half + tt2) + fr; const float et = __expf(cuml[hh * 64 + t]); float ss = 0.f;
#pragma unroll
        for (int pt = 0; pt < 4; ++pt) { const int pp = 16 * pt + 4 * G; const u32x2 zz = zpre[tt2][pt];
            const float zf[4] = {bflo(zz[0]), bfhi(zz[0]), bflo(zz[1]), bfhi(zz[1])};
#pragma unroll
            for (int r = 0; r < 4; ++r) { const float xv = bflo((unsigned)XT[(hh * 64 + pp + r) * 72 + swz8(pp + r, t)]); float y = acc1[tt2][pt][r] + et * acc2[tt2][pt][r] + dsk * xv; y *= silu_f(zf[r]); acc1[tt2][pt][r] = y; ss += y * y; } }
        ss += __shfl_xor(ss, 16); ss += __shfl_xor(ss, 32);
        if (G == 0) SS[hh * 64 + t] = ss; }
    __syncthreads();
#pragma unroll
    for (int tt2 = 0; tt2 < 2; ++tt2) { const int t = 16 * (2 * half + tt2) + fr; const float tot = SS[t] + SS[64 + t] + SS[128 + t] + SS[192 + t]; const float rstd = rsqrtf(tot * (1.f / 256.f) + 1e-5f);
#pragma unroll
        for (int pt = 0; pt < 4; ++pt) { const int pp = 16 * pt + 4 * G; const float4 ng = *(const float4*)(p.norm_g_d + h * 64 + pp);
            *(u32x2*)(MIX + (U.row0 + t) * DM + 512 + h * 64 + pp) = (u32x2){pk2(acc1[tt2][pt][0] * rstd * ng.x, acc1[tt2][pt][1] * rstd * ng.y), pk2(acc1[tt2][pt][2] * rstd * ng.z, acc1[tt2][pt][3] * rstd * ng.w)}; } }
    __syncthreads();
}

#ifndef REP9A
#define REP9A 0
#endif
#ifndef REP9S
#define REP9S 0
#endif
#ifndef REPM
#define REPM 0
#endif
#define PHASE(n, ...) if (p.ph_lo <= (n) && (n) < p.ph_hi) { if ((n) > p.ph_lo) { if (p.ph_hi > 1000) grid.sync(); else xcd_barrier(xb); } if (PHM & (1u << (n))) { __VA_ARGS__; } if (REPM & (1u << (n))) { __syncthreads(); __VA_ARGS__; } }
#define PHASER(n, rep, ...) if (p.ph_lo <= (n) && (n) < p.ph_hi) { if ((n) > p.ph_lo) { if ((n) == 1) grid.sync(); else xcd_barrier(xb); } if (PHM & (1u << (n))) { __VA_ARGS__; } if (REPM & (1u << (n))) { __syncthreads(); rep; } }
__global__ void __launch_bounds__(512, 2) mega(Params p) {
    extern __shared__ __attribute__((aligned(16))) unsigned char lds[];
    cg::grid_group grid = cg::this_grid();
    volatile LAS unsigned* xst = (volatile LAS unsigned*)((LAS unsigned char*)lds + 131072);
    if (threadIdx.x < 4) xst[threadIdx.x] = 0u;
    __syncthreads();
    const XcdBarrier xb = xcd_barrier_post((unsigned*)(p.ws + WS_BAR), xst);
    bf16_t* HB = (bf16_t*)(p.ws + WS_XN); bf16_t* PROJ = (bf16_t*)(p.ws + WS_PROJ); bf16_t* MIX = (bf16_t*)(p.ws + WS_MIX);
    ssq_t* SS0 = (ssq_t*)(p.ws + WS_SS); ssq_t* SS1 = SS0 + MT; ssq_t* SS2 = SS1 + MT; ssq_t* SS3 = SS2 + MT; ssq_t* SS4 = SS3 + MT; float* DTB = (float*)(p.ws + WS_DT);
    const bf16_t* WGU = (const bf16_t*)(p.ws + WS_WT_GU); const bf16_t* WDN = (const bf16_t*)(p.ws + WS_WT_DN);
    const bf16_t* WINAB = (const bf16_t*)(p.ws + WS_WT_INAB); const bf16_t* WOUTAB = (const bf16_t*)(p.ws + WS_WT_OUTAB); const bf16_t* WINCD = (const bf16_t*)(p.ws + WS_WT_INCD); const bf16_t* WOUTCD = (const bf16_t*)(p.ws + WS_WT_OUTCD);
#ifdef EXTRA_SYNC
    for (int i = 0; i < EXTRA_SYNC; ++i) xcd_barrier(xb);
#endif
    PHASE(0, phase_prep(p, lds); phase_convert_x(p))
    PHASE(1, run_gemm(lds, HB, WINAB, NAB, DM, EpiProjAB{PROJ, SS0}); small_gemm<0>(p, lds, HB, WINAB, DM, NAB / 64, SS0, nullptr, nullptr, nullptr))
    PHASE(2, phase_mixer_ab(p, lds))
    PHASE(3, run_gemm(lds, MIX, WOUTAB, DM, DM, EpiRes{HB, p.x_prompt, SS1}); small_gemm<1>(p, lds, MIX, WOUTAB, DM, DM / 64, nullptr, HB, p.x_sample, SS1))
    PHASE(5, run_gemm(lds, HB, WGU, 2 * FH, DM, EpiSwiglu{PROJ, SS1}); small_gemm<2>(p, lds, HB, WGU, DM, FH / 32, SS1, nullptr, nullptr, nullptr))
    PHASE(6, run_gemm(lds, PROJ, WDN, DM, FH, EpiRes{HB, nullptr, SS2}); small_gemm<1>(p, lds, PROJ, WDN, FH, DM / 64, nullptr, HB, nullptr, SS2))
    PHASE(8, run_gemm(lds, HB, WINCD, NCDP, DM, EpiProjCD{PROJ, p.out, SS2, DTB}); small_gemm<3>(p, lds, HB, WINCD, DM, NCD / 64 + 1, SS2, nullptr, nullptr, nullptr))
    PHASE(9, { int u = blockIdx.x;
        for (; u < N_ATT; u += gridDim.x) { const int w = u < N_ATT_P ? ((u & 7) * 256 + (u >> 3)) : u; att_unit(p, lds, w); }
        { u32x4 rws[11]; const int v0 = u - N_ATT; ssd_rows_load(p, ssd_decode(v0 < N_SSD ? v0 : 0), rws);
          for (; u < N_ATT + N_SSD; u += gridDim.x) { const int v = u - N_ATT, vn = v + (int)gridDim.x < N_SSD ? v + (int)gridDim.x : v; ssd_state_unit(p, lds, v, vn, rws); } }
        for (; u < N_ATT + N_SSD + 16; u += gridDim.x) { u32x4 rws[11]; ssd_out_unit<false>(p, lds, 2048 + (u - N_ATT - N_SSD), 0, rws); } })
    PHASE(10, phase_scan(p))
    PHASE(11, { u32x4 rws[11]; int u = blockIdx.x; ssd_rows_load(p, ssd_decode(u < 2048 ? u : 0), rws);
        for (; u < 2048; u += gridDim.x) { const int un = u + (int)gridDim.x < 2048 ? u + (int)gridDim.x : u; ssd_out_unit<true>(p, lds, u, un, rws); } })
    PHASE(12, run_gemm(lds, MIX, WOUTCD, DM, DM, EpiRes{HB, nullptr, SS3}); small_gemm<1>(p, lds, MIX, WOUTCD, DM, DM / 64, nullptr, HB, nullptr, SS3))
    PHASE(14, run_gemm(lds, HB, WGU + (size_t)2 * FH * DM, 2 * FH, DM, EpiSwiglu{PROJ, SS3}); small_gemm<2>(p, lds, HB, WGU + (size_t)2 * FH * DM, DM, FH / 32, SS3, nullptr, nullptr, nullptr))
    PHASE(15, run_gemm(lds, PROJ, WDN + (size_t)DM * FH, DM, FH, EpiRes{HB, nullptr, SS4}); small_gemm<1>(p, lds, PROJ, WDN + (size_t)DM * FH, FH, DM / 64, nullptr, HB, nullptr, SS4))
    PHASE(16, phase_final_norm(p))
}

extern "C" void kernel_launch(void* const* d_in, const int* in_sizes, int n_in, void* d_out, int out_size, void* d_ws, size_t ws_size, hipStream_t stream) {
    static int grid = 0;
    if (grid == 0) {
        int dev = 0, cus = 0, per_cu = 0;
        hipGetDevice(&dev); hipDeviceGetAttribute(&cus, hipDeviceAttributeMultiprocessorCount, dev);
        if (hipFuncSetAttribute((const void*)mega, hipFuncAttributeMaxDynamicSharedMemorySize, LDS_BYTES) != hipSuccess) fprintf(stderr, "kernel_launch: hipFuncSetAttribute failed\n");
        if (hipOccupancyMaxActiveBlocksPerMultiprocessor(&per_cu, (const void*)mega, 512, LDS_BYTES) != hipSuccess || per_cu < 1) { fprintf(stderr, "kernel_launch: occupancy query gave %d\n", per_cu); per_cu = 1; }
        (void)hipGetLastError();
        if (cus <= 0) cus = 256;
        grid = cus;
        if (n_in != 29 || (size_t)out_size != O_END || ws_size < WS_END) fprintf(stderr, "kernel_launch: unexpected sizes n_in %d out %d ws %zu (need %zu)\n", n_in, out_size, ws_size, (size_t)WS_END);
    }
    Params p{};
    const float** pp = (const float**)&p;
    for (int i = 0; i < 29; ++i) pp[i] = (const float*)d_in[i];
    p.out = (float*)d_out; p.ws = (unsigned char*)d_ws;
    if (hipMemsetAsync((unsigned char*)d_ws + WS_BAR, 0, 16384, stream) != hipSuccess) fprintf(stderr, "kernel_launch: memset of the barrier words failed\n");
#if PER_PHASE_LAUNCH
    for (int ph = 0; ph < NPH; ++ph) { p.ph_lo = ph; p.ph_hi = ph + 1; hipLaunchKernelGGL(mega, dim3(grid), dim3(512), LDS_BYTES, stream, p); }
#else
    p.ph_lo = 0; p.ph_hi = NPH; void* args[] = {&p};
    hipError_t e = hipLaunchCooperativeKernel((const void*)mega, dim3(grid), dim3(512), args, LDS_BYTES, stream);
    if (e != hipSuccess) fprintf(stderr, "kernel_launch: cooperative launch failed: %s (grid %d)\n", hipGetErrorString(e), grid);
#endif
}
```

```cpp
#include <hip/hip_runtime.h>
#include <hip/hip_cooperative_groups.h>
#include <cstdio>
namespace cg = cooperative_groups;
#ifndef PER_PHASE_LAUNCH
#define PER_PHASE_LAUNCH 0
#endif
namespace pg8 {
#define PG8_LAS __attribute__((address_space(3)))
typedef unsigned short bf16_t;
typedef short bf16x8 __attribute__((ext_vector_type(8)));
typedef float f32x4 __attribute__((ext_vector_type(4)));
typedef unsigned u32x4 __attribute__((ext_vector_type(4)));
constexpr int BM = 256, BK = 64, HALF = 128, HTB = HALF * BK * 2  , STAGE_BYTES = 8 * HTB, NXCD = 8, WGM = 4;

__host__ __device__ __forceinline__ int lds_byte(int r, int c) { const int st = (r >> 4) * 2 + (c >> 5), rr = r & 15, cc = c & 31, ob = rr * 64 + cc * 2; return st * 1024 + (ob ^ (((ob >> 9) & 1) << 5)); }
__host__ __device__ __forceinline__ void stage_rc(int b, int& R, int& C) { const int st = b / 1024, sb = b % 1024, swz = sb ^ (((sb >> 9) & 1) << 5); R = (st >> 1) * 16 + swz / 64; C = (st & 1) * 32 + (swz % 64) / 2; }
__host__ __device__ __forceinline__ int perm32(int rho) { const int n = rho >> 4, i = rho & 15; return 8 * (i >> 2) + 4 * n + (i & 3); }

struct Unit { int pm, pn; };
struct Gemm { const bf16_t* A; const bf16_t* Bt; int M, N, K; };

struct StaticOrder {
    int nM, nN, nwg, G, c;
    __host__ __device__ void init(int M, int N, int G_, int c_) { nM = M / BM; nN = N / BM; nwg = nM * nN; G = G_; c = c_; }
    __host__ __device__ bool next(int i, Unit& u) const {
        const long L = (long)i * G + c; if (L >= nwg) return false;
        int wgid = (int)L; { const int q = nwg / NXCD, r = nwg % NXCD, xcd = wgid % NXCD, off = wgid / NXCD; wgid = (xcd < r ? xcd * (q + 1) : r * (q + 1) + (xcd - r) * q) + off; }
        const int nig = WGM * nN, gid = wgid / nig, fm = gid * WGM, gsz = (nM - fm) < WGM ? (nM - fm) : WGM;
        u.pm = fm + ((wgid % nig) % gsz); u.pn = (wgid % nig) / gsz; return true;
    }
    __device__ __forceinline__ void a_ready(const Unit&) const {}
    __device__ __forceinline__ void done(const Unit&) const {}
};
__device__ __forceinline__ unsigned cvt_pk_bf16(float lo, float hi) { unsigned r; asm volatile("v_cvt_pk_bf16_f32 %0, %1, %2" : "=v"(r) : "v"(lo), "v"(hi)); return r; }
typedef float f32x2 __attribute__((ext_vector_type(2)));
__device__ __forceinline__ f32x2 gelu_pk(f32x2 v) {
    const f32x2 av = __builtin_elementwise_abs(v), d = av * 0.2316418882f + 1.0f;
    f32x2 t; t.x = __builtin_amdgcn_rcpf(d.x); t.y = __builtin_amdgcn_rcpf(d.y);
    f32x2 q = t * 0.5307027145f + (-0.7265760135f); q = q * t + 0.7107068705f; q = q * t + (-0.142248368f); q = q * t + 0.127414796f; q = q * t;
    const f32x2 s = (v * v) * (-0.72134752044f);
    f32x2 e; e.x = __builtin_amdgcn_exp2f(s.x); e.y = __builtin_amdgcn_exp2f(s.y);
    const f32x2 m = v * (q * e), r = v - m;
    f32x2 o; o.x = v.x < 0.f ? m.x : r.x; o.y = v.y < 0.f ? m.y : r.y; return o;
}
template <class Epi, class Sched, bool STAMP = false>
__device__ __forceinline__ void gemm_phase(PG8_LAS unsigned char* lds, const Gemm g, const Sched& S, const Epi& E, unsigned long long* stamps) {
    int tid_l = threadIdx.x; asm volatile("" : "+v"(tid_l)); const int tid = tid_l, wid = __builtin_amdgcn_readfirstlane(tid >> 6), lane = tid & 63, wr = wid >> 2, wc = wid & 3, fr = lane & 15, fq = lane >> 4;
    const int K = g.K, nt = K / BK;
    int ts_lo = 0, ts_hi = 0, nts = 0; const unsigned long long rt_entry = STAMP ? (unsigned long long)wall_clock64() : 0ull;
#define PG8_STAMP() do { if (STAMP && wid == 0 && nts < 64) { const unsigned long long _c = (unsigned long long)clock64(); \
        ts_lo = (lane == nts) ? (int)(unsigned)_c : ts_lo; ts_hi = (lane == nts) ? (int)(unsigned)(_c >> 32) : ts_hi; ++nts; } } while (0)
    PG8_STAMP();
    unsigned voffA[2], voffB[2];
#pragma unroll
    for (int i = 0; i < 2; ++i) { int R, C; stage_rc(tid * 16 + i * 8192, R, C); const int Rb = Epi::PERM ? ((R & ~31) + perm32(R & 31)) : R;
        voffA[i] = (unsigned)(R * K + C) * 2u; voffB[i] = (unsigned)(Rb * K + C) * 2u; }
    const size_t kstep = (size_t)(BK * 2);
    const size_t hstep = (size_t)HALF * K * 2;
    const size_t tstep = 2 * hstep;
    const unsigned ldsw = (unsigned)wid * 1024u;
    const int aoff = lds_byte(wr * 64 + fr, fq * 8), boff = lds_byte(wc * 32 + fr, fq * 8);
#define PG8_SA(b, h) (((b) * 2 + (h)) * HTB)
#define PG8_SB(b, h) ((4 + (b) * 2 + (h)) * HTB)
#define PG8_STAGE(bufoff, gbase, voff) do { _Pragma("unroll") for (int _i = 0; _i < 2; ++_i) \
        __builtin_amdgcn_global_load_lds((const unsigned*)((const char*)(gbase) + (voff)[_i]), (PG8_LAS unsigned*)(lds + (bufoff) + ldsw + _i * 8192), 16, 0, 0); } while (0)
#define PG8_LDA(dst, b, h) do { _Pragma("unroll") for (int m = 0; m < 4; ++m) _Pragma("unroll") for (int k = 0; k < 2; ++k) dst[m][k] = *(const PG8_LAS bf16x8*)(lds + PG8_SA(b, h) + aoff + m * 2048 + k * 1024); } while (0)
#define PG8_LDB(dst, b, h) do { _Pragma("unroll") for (int n = 0; n < 2; ++n) _Pragma("unroll") for (int k = 0; k < 2; ++k) dst[n][k] = *(const PG8_LAS bf16x8*)(lds + PG8_SB(b, h) + boff + n * 2048 + k * 1024); } while (0)
#define PG8_MMA(ai, bj, At, Bt) do { __builtin_amdgcn_s_setprio(1); _Pragma("unroll") for (int m = 0; m < 4; ++m) _Pragma("unroll") for (int n = 0; n < 2; ++n) _Pragma("unroll") for (int k = 0; k < 2; ++k) \
        acc[ai][bj][m][n] = __builtin_amdgcn_mfma_f32_16x16x32_bf16(Bt[n][k], At[m][k], acc[ai][bj][m][n], 0, 0, 0); __builtin_amdgcn_s_setprio(0); } while (0)
#define PG8_WAIT_V(n) asm volatile("s_waitcnt vmcnt(" #n ")" ::: "memory")
#define PG8_WAIT_L(n) asm volatile("s_waitcnt lgkmcnt(" #n ")" ::: "memory")
#define PG8_BAR __builtin_amdgcn_s_barrier()
#define PG8_SCHED __builtin_amdgcn_sched_barrier(0)
    Unit cur, nxt; int ui = 0;
    if (!S.next(0, cur)) return;
    f32x4 acc[2][2][4][2];
#pragma unroll
    for (int a = 0; a < 2; ++a)
#pragma unroll
        for (int b = 0; b < 2; ++b)
#pragma unroll
            for (int m = 0; m < 4; ++m)
#pragma unroll
                for (int n = 0; n < 2; ++n) acc[a][b][m][n] = (f32x4){0.f, 0.f, 0.f, 0.f};
    bf16x8 At[4][2], B0[2][2], B1[2][2];
    const char* cA = (const char*)g.A + (size_t)cur.pm * tstep; const char* cB = (const char*)g.Bt + (size_t)cur.pn * tstep;
    S.a_ready(cur);
    PG8_STAGE(PG8_SB(0, 0), cB, voffB); PG8_STAGE(PG8_SA(0, 0), cA, voffA); PG8_STAGE(PG8_SB(0, 1), cB + hstep, voffB); PG8_STAGE(PG8_SA(0, 1), cA + hstep, voffA);
    if (wr == 1) PG8_BAR;
    PG8_WAIT_V(4); PG8_BAR;
    PG8_STAGE(PG8_SB(1, 0), cB + kstep, voffB); PG8_STAGE(PG8_SA(1, 0), cA + kstep, voffA); PG8_STAGE(PG8_SB(1, 1), cB + hstep + kstep, voffB);
    PG8_WAIT_V(6); PG8_BAR;
    PG8_STAMP();
    for (;;) {
        const bool has_next = S.next(ui + 1, nxt);
        const char* nA = has_next ? (const char*)g.A + (size_t)nxt.pm * tstep : cA; const char* nB = has_next ? (const char*)g.Bt + (size_t)nxt.pn * tstep : cB;
        for (int t = 0; t < nt; t += 2) {
            const bool last = (t == nt - 2);
            const char* a1 = cA + (size_t)(t + 1) * kstep;
            const char* a2 = last ? nA : cA + (size_t)(t + 2) * kstep; const char* b2 = last ? nB : cB + (size_t)(t + 2) * kstep;
            const char* a3 = a2 + kstep; const char* b3 = b2 + kstep;
            if (last && has_next) S.a_ready(nxt);
            PG8_LDB(B0, 0, 0); PG8_SCHED; PG8_LDA(At, 0, 0); PG8_STAGE(PG8_SA(1, 1), a1 + hstep, voffA);
            PG8_WAIT_L(8); PG8_BAR; PG8_WAIT_L(0); PG8_MMA(0, 0, At, B0); PG8_BAR; PG8_SCHED;
            PG8_LDB(B1, 0, 1); PG8_STAGE(PG8_SB(0, 0), b2, voffB);
            PG8_BAR; PG8_WAIT_L(0); PG8_MMA(0, 1, At, B1); PG8_BAR;
            PG8_LDA(At, 0, 1); PG8_STAGE(PG8_SA(0, 0), a2, voffA);
            PG8_BAR; PG8_WAIT_L(0); PG8_MMA(1, 0, At, B0); PG8_BAR; PG8_SCHED;
            PG8_STAGE(PG8_SB(0, 1), b2 + hstep, voffB);
            PG8_WAIT_V(6); PG8_BAR; PG8_MMA(1, 1, At, B1); PG8_BAR;
            PG8_LDB(B0, 1, 0); PG8_SCHED; PG8_LDA(At, 1, 0); PG8_STAGE(PG8_SA(0, 1), a2 + hstep, voffA);
            PG8_WAIT_L(8); PG8_BAR; PG8_WAIT_L(0); PG8_MMA(0, 0, At, B0); PG8_BAR; PG8_SCHED;
            PG8_LDB(B1, 1, 1); PG8_STAGE(PG8_SB(1, 0), b3, voffB);
            PG8_BAR; PG8_WAIT_L(0); PG8_MMA(0, 1, At, B1); PG8_BAR;
            PG8_LDA(At, 1, 1); PG8_STAGE(PG8_SA(1, 0), a3, voffA);
            PG8_BAR; PG8_WAIT_L(0); PG8_MMA(1, 0, At, B0); PG8_BAR; PG8_SCHED;
            PG8_STAGE(PG8_SB(1, 1), b3 + hstep, voffB);
            PG8_WAIT_V(6); PG8_BAR; PG8_MMA(1, 1, At, B1); PG8_BAR;
        }
        PG8_STAMP();
        if constexpr (!Epi::AFTER_DRAIN) { E(acc, cur, wr, wc, fr, fq); S.done(cur); }
        PG8_STAMP();
        if (!has_next) break;
#pragma unroll
        for (int a = 0; a < 2; ++a)
#pragma unroll
            for (int b = 0; b < 2; ++b)
#pragma unroll
                for (int m = 0; m < 4; ++m)
#pragma unroll
                    for (int n = 0; n < 2; ++n) acc[a][b][m][n] = (f32x4){0.f, 0.f, 0.f, 0.f};
        cur = nxt; cA = nA; cB = nB; ++ui;
    }
    PG8_WAIT_V(0);
    if (wr == 0) PG8_BAR;
    PG8_BAR;
    if constexpr (Epi::AFTER_DRAIN) { E.fused(acc, cur, wr, wc, fr, fq, lds, wid, lane); S.done(cur); }
    PG8_STAMP();
    if (STAMP && wid == 0) { stamps[lane] = lane < nts ? (((unsigned long long)(unsigned)ts_hi << 32) | (unsigned)ts_lo) : 0ull;
        if (lane == 62) stamps[62] = rt_entry; if (lane == 63) stamps[63] = (unsigned long long)wall_clock64(); }
#undef PG8_STAMP
#undef PG8_SA
#undef PG8_SB
#undef PG8_STAGE
#undef PG8_LDA
#undef PG8_LDB
#undef PG8_MMA
#undef PG8_WAIT_V
#undef PG8_WAIT_L
#undef PG8_BAR
#undef PG8_SCHED
}
}
#define XB_TMO      128
#define XB_XCNT(j)  (256  + 64 * (j))
#define XB_XSUB(j)  (1280 + 64 * (j))
#define XB_XGEN(j)  (2304 + 64 * (j))
#define XB_TOP      3328
#define XB_TOPGEN   3392
#define XCD_BAR_WORDS 3456
#define XB_SPIN_CAP (1u << 18)
#define LAS __attribute__((address_space(3)))

__device__ __forceinline__ unsigned xb_ld(unsigned* p)              { return __hip_atomic_load(p, __ATOMIC_RELAXED, __HIP_MEMORY_SCOPE_AGENT); }
__device__ __forceinline__ unsigned xb_add(unsigned* p, unsigned v) { return __hip_atomic_fetch_add(p, v, __ATOMIC_RELAXED, __HIP_MEMORY_SCOPE_AGENT); }
__device__ __forceinline__ unsigned xb_xcc_id() { return (unsigned)__builtin_amdgcn_s_getreg((3 << 11) | 20) & 0xFu; }
#define XB_SPIN(cond, bar) do { unsigned _sp = 0; while (cond) { __builtin_amdgcn_s_sleep(1); \
    if ((++_sp & 255u) == 0u) { if (xb_ld(&(bar)[XB_TMO])) break; if (_sp > XB_SPIN_CAP) { atomicAdd(&(bar)[XB_TMO], 1u); break; } } } } while (0)

struct XcdBarrier {
    unsigned* bar; unsigned x;
    volatile LAS unsigned* st;
};

__device__ __forceinline__ XcdBarrier xcd_barrier_post(unsigned* bar, volatile LAS unsigned* st) {
    XcdBarrier b; b.bar = bar; b.x = xb_xcc_id(); b.st = st;
    if (threadIdx.x == 0) (void)xb_add(&bar[XB_XCNT(b.x)], 1u);
    return b;
}
__device__ __forceinline__ void xcd_barrier_complete(unsigned* bar, unsigned x, unsigned& nloc, unsigned& nx) {
    const unsigned G = gridDim.x * gridDim.y * gridDim.z;
    unsigned sum, cnt, mine, sp = 0u;
    for (;;) {
        sum = 0u; cnt = 0u; mine = 0u;
#pragma unroll
        for (unsigned j = 0; j < 16; ++j) { const unsigned c = xb_ld(&bar[XB_XCNT(j)]); sum += c; cnt += (c > 0u) ? 1u : 0u; mine = (j == x) ? c : mine; }
        if (sum == G) break;
        __builtin_amdgcn_s_sleep(1);
        if ((++sp & 255u) == 0u) { if (xb_ld(&bar[XB_TMO])) break; if (sp > XB_SPIN_CAP) { atomicAdd(&bar[XB_TMO], 1u); break; } }
    }
    nloc = mine > 0u ? mine : 1u; nx = cnt > 0u ? cnt : 1u;
}

__device__ __forceinline__ void xcd_barrier(const XcdBarrier& b) {
    asm volatile("s_waitcnt vmcnt(0)" ::: "memory");
    __syncthreads();
    if (threadIdx.x == 0) {
        unsigned* bar = b.bar;
        __builtin_amdgcn_s_waitcnt(0);
        unsigned nloc = b.st[0], nx = b.st[1];
        if (nloc == 0u) { xcd_barrier_complete(bar, b.x, nloc, nx); b.st[0] = nloc; b.st[1] = nx; }
        const unsigned old = xb_add(&bar[XB_XSUB(b.x)], 1u);
        const unsigned gen = old / nloc;
        if (old + 1u == (gen + 1u) * nloc) {
            __builtin_amdgcn_fence(__ATOMIC_RELEASE, "agent");
            asm volatile("s_waitcnt vmcnt(0)" ::: "memory");
            const unsigned og = xb_add(&bar[XB_TOP], 1u);
            const unsigned tg = og / nx;
            if (og + 1u == (tg + 1u) * nx) xb_add(&bar[XB_TOPGEN], 1u);
            else XB_SPIN(xb_ld(&bar[XB_TOPGEN]) == tg, bar);
            __builtin_amdgcn_fence(__ATOMIC_ACQUIRE, "agent");
            xb_add(&bar[XB_XGEN(b.x)], 1u);
            asm volatile("s_waitcnt vmcnt(0)" ::: "memory");
        } else {
            XB_SPIN(xb_ld(&bar[XB_XGEN(b.x)]) == gen, bar);
            __builtin_amdgcn_fence(__ATOMIC_ACQUIRE, "agent");
            asm volatile("s_waitcnt vmcnt(0)" ::: "memory");
        }
    }
    __syncthreads();
}


using pg8::bf16_t; using pg8::bf16x8; using pg8::f32x4; using pg8::u32x4; using pg8::f32x2;
typedef unsigned u32x2 __attribute__((ext_vector_type(2)));

constexpr int MP = 65536, MS = 512, MT = MP + MS, DM = 1024;
constexpr int NAB = 2560, NCD = 3072, NCDF = 3080, NCDP = 3328, FH = 2816;
constexpr int NPH = 17;
constexpr float RMS_EPS = 1e-5f;
#ifndef PHM
#define PHM 0xFFFFF
#endif
constexpr int LDS_BYTES = 131072 + 64;

constexpr size_t O_Y_P = 0;
constexpr size_t O_Y_S = O_Y_P + (size_t)MP * DM;
constexpr size_t O_CONVA_P = O_Y_S + (size_t)MS * DM;
constexpr size_t O_CONVA_S = O_CONVA_P + 16 * 2 * 512;
constexpr size_t O_VB_S = O_CONVA_S + 8 * 2 * 512;
constexpr size_t O_KC_P = O_VB_S + 8 * 64 * 512;
constexpr size_t O_VC_P = O_KC_P + (size_t)16 * 512 * 512;
constexpr size_t O_KC_S = O_VC_P + (size_t)16 * 512 * 512;
constexpr size_t O_VC_S = O_KC_S + 8 * 64 * 512;
constexpr size_t O_CONVD_P = O_VC_S + 8 * 64 * 512;
constexpr size_t O_CONVD_S = O_CONVD_P + 16 * 3 * 1024;
constexpr size_t O_SSM_P = O_CONVD_S + 8 * 3 * 1024;
constexpr size_t O_SSM_S = O_SSM_P + (size_t)16 * 65536;
constexpr size_t O_END = O_SSM_S + (size_t)8 * 65536;

constexpr size_t WS_WT_INAB = 0;
constexpr size_t WS_WT_OUTAB = WS_WT_INAB + (size_t)NAB * DM * 2;
constexpr size_t WS_WT_INCD = WS_WT_OUTAB + (size_t)DM * DM * 2;
constexpr size_t WS_WT_OUTCD = WS_WT_INCD + (size_t)NCDP * DM * 2;
constexpr size_t WS_WT_GU = WS_WT_OUTCD + (size_t)DM * DM * 2;
constexpr size_t WS_WT_DN = WS_WT_GU + (size_t)2 * 2 * FH * DM * 2;
constexpr size_t WS_XN = WS_WT_DN + (size_t)2 * DM * FH * 2;
constexpr size_t WS_PROJ = WS_XN + (size_t)MT * DM * 2;
constexpr size_t WS_MIX = WS_PROJ + (size_t)MT * NCD * 2;
constexpr size_t WS_SBUF = WS_MIX + (size_t)MT * DM * 2;
constexpr size_t WS_DT = WS_SBUF + (size_t)1032 * 65536 * 4;
constexpr size_t WS_DEC = WS_DT + (size_t)MT * 8 * 4;
constexpr size_t WS_CK = WS_DEC + (size_t)1032 * 8 * 4 + 128;
constexpr size_t WS_CV = WS_CK + (size_t)8 * 512 * 512 * 2;
constexpr size_t WS_BAR = WS_CV + (size_t)8 * 512 * 512 * 2;
constexpr size_t WS_SS = WS_BAR + 16384;
constexpr size_t WS_HD = WS_SS + (size_t)5 * MT * 8;
constexpr size_t WS_WSB = WS_HD + (size_t)(8 * 3 + 1) * 1024 * 2;
constexpr size_t WS_END = WS_WSB + (size_t)4 * 128 * 128 * 2;

struct Params {
    const float *x_prompt, *x_sample, *cache_k, *cache_v, *state_conv_a, *state_conv_d, *state_ssm_d;
    const float *norm_mix, *norm_ffn, *norm_final, *w_in_ab, *conv_w_a, *ln_g_b, *ln_b_b, *w_s_b, *b_s_b, *w_out_ab, *w_in_cd, *rel_bias_c, *conv_w_d, *conv_b_d,
        *dt_bias_d, *a_log_d, *d_skip_d, *norm_g_d, *w_out_cd, *w_gate, *w_up, *w_down;
    float* out; unsigned char* ws;
    int ph_lo, ph_hi;
};

__device__ __forceinline__ int ltid() { int t = threadIdx.x; asm volatile("" : "+v"(t)); return t; }
__device__ __forceinline__ unsigned pk2(float lo, float hi) { unsigned r; asm("v_cvt_pk_bf16_f32 %0, %1, %2" : "=v"(r) : "v"(lo), "v"(hi)); return r; }
__device__ __forceinline__ unsigned short f2bf(float f) { return (unsigned short)(pk2(f, 0.f) & 0xffffu); }
__device__ __forceinline__ float bflo(unsigned w) { return __uint_as_float(w << 16); }
__device__ __forceinline__ float bfhi(unsigned w) { return __uint_as_float(w & 0xffff0000u); }
#define UNPACK8(v, f) do { f[0] = bflo(v[0]); f[1] = bfhi(v[0]); f[2] = bflo(v[1]); f[3] = bfhi(v[1]); f[4] = bflo(v[2]); f[5] = bfhi(v[2]); f[6] = bflo(v[3]); f[7] = bfhi(v[3]); } while (0)
#define PACK8(f) ((u32x4){pk2(f[0], f[1]), pk2(f[2], f[3]), pk2(f[4], f[5]), pk2(f[6], f[7])})
__device__ __forceinline__ float wave_sum(float v) {
#pragma unroll
    for (int o = 32; o; o >>= 1) v += __shfl_xor(v, o);
    return v;
}
__device__ __forceinline__ float silu_f(float x) { return x * __builtin_amdgcn_rcpf(1.f + __expf(-x)); }
__device__ __forceinline__ bf16x8 as_bf16x8(u32x4 v) { union { u32x4 u; bf16x8 b; } c; c.u = v; return c.b; }
__device__ __forceinline__ int swz8(int row, int col) { return col ^ (((row >> 3) & 7) << 3); }
__device__ __forceinline__ int swz16(int row, int col) { return col ^ (((row >> 3) & 15) << 3); }
__device__ __forceinline__ int swzv(int c, int t) { return t ^ ((((c >> 3) ^ c) & 15) << 3); }
typedef _Float16 h16x2 __attribute__((ext_vector_type(2)));
__device__ __forceinline__ unsigned pkh2(float lo, float hi) { union { h16x2 h; unsigned u; } c; c.h = (h16x2){(_Float16)lo, (_Float16)hi}; return c.u; }
__device__ __forceinline__ float h16lo(unsigned w) { union { h16x2 h; unsigned u; } c; c.u = w; return (float)c.h[0]; }
__device__ __forceinline__ float h16hi(unsigned w) { union { h16x2 h; unsigned u; } c; c.u = w; return (float)c.h[1]; }
#define MFMA16(a, b, c) __builtin_amdgcn_mfma_f32_16x16x32_bf16((a), (b), (c), 0, 0, 0)

typedef unsigned long long ssq_t;
__device__ __forceinline__ ssq_t ssq_fix(float ss) { return (ssq_t)(ss * 1048576.f + 0.5f); }
__device__ __forceinline__ float rstd_of(const ssq_t* SS, int row) { return rsqrtf((float)SS[row] * (1.f / (1048576.f * 1024.f)) + RMS_EPS); }
struct EpiProjAB {
    static constexpr bool PERM = true, AFTER_DRAIN = false;
    bf16_t* O; const ssq_t* SS;
    __device__ __forceinline__ void operator()(const f32x4 (&acc)[2][2][4][2], const pg8::Unit& u, int wr, int wc, int fr, int fq) const {
        const int row0 = u.pm * 256 + wr * 64 + fr, col0 = u.pn * 256 + wc * 32 + 8 * fq;
        const bool act = u.pn >= 6;
#pragma unroll
        for (int ai = 0; ai < 2; ++ai)
#pragma unroll
            for (int m = 0; m < 4; ++m) { const int r = row0 + ai * 128 + m * 16; const float rs = rstd_of(SS, r); bf16_t* rowp = O + (size_t)r * NAB + col0;
#pragma unroll
                for (int bj = 0; bj < 2; ++bj) { f32x4 v0 = acc[ai][bj][m][0] * rs, v1 = acc[ai][bj][m][1] * rs;
                    if (act) { f32x2 a = pg8::gelu_pk((f32x2){v0[0], v0[1]}), b = pg8::gelu_pk((f32x2){v0[2], v0[3]}), c = pg8::gelu_pk((f32x2){v1[0], v1[1]}), d = pg8::gelu_pk((f32x2){v1[2], v1[3]});
                        v0 = (f32x4){a.x, a.y, b.x, b.y}; v1 = (f32x4){c.x, c.y, d.x, d.y}; }
                    *(u32x4*)(rowp + bj * 128) = (u32x4){pk2(v0[0], v0[1]), pk2(v0[2], v0[3]), pk2(v1[0], v1[1]), pk2(v1[2], v1[3])}; } }
    }
};
struct EpiRes {
    static constexpr bool PERM = true, AFTER_DRAIN = false;
    bf16_t* HB; const float* Rf; ssq_t* SSo;
    __device__ __forceinline__ void operator()(const f32x4 (&acc)[2][2][4][2], const pg8::Unit& u, int wr, int wc, int fr, int fq) const {
        const int row0 = u.pm * 256 + wr * 64 + fr, col0 = u.pn * 256 + wc * 32 + 8 * fq;
#pragma unroll
        for (int ai = 0; ai < 2; ++ai)
#pragma unroll
            for (int m = 0; m < 4; ++m) { const int r = row0 + ai * 128 + m * 16; bf16_t* hp = HB + (size_t)r * DM + col0; float ss = 0.f;
#pragma unroll
                for (int bj = 0; bj < 2; ++bj) { f32x4 v0 = acc[ai][bj][m][0], v1 = acc[ai][bj][m][1];
                    if (Rf) { const float* rp = Rf + (size_t)r * DM + col0 + bj * 128; v0 += *(const f32x4*)rp; v1 += *(const f32x4*)(rp + 4); }
                    else { const u32x4 hv = *(const u32x4*)(hp + bj * 128); v0 += (f32x4){bflo(hv[0]), bfhi(hv[0]), bflo(hv[1]), bfhi(hv[1])}; v1 += (f32x4){bflo(hv[2]), bfhi(hv[2]), bflo(hv[3]), bfhi(hv[3])}; }
                    ss += v0[0] * v0[0] + v0[1] * v0[1] + v0[2] * v0[2] + v0[3] * v0[3] + v1[0] * v1[0] + v1[1] * v1[1] + v1[2] * v1[2] + v1[3] * v1[3];
                    *(u32x4*)(hp + bj * 128) = (u32x4){pk2(v0[0], v0[1]), pk2(v0[2], v0[3]), pk2(v1[0], v1[1]), pk2(v1[2], v1[3])}; }
                ss += __shfl_xor(ss, 16); ss += __shfl_xor(ss, 32);
                if (fq == 0) atomicAdd(SSo + r, ssq_fix(ss)); }
    }
};
struct EpiSwiglu {
    static constexpr bool PERM = true, AFTER_DRAIN = false;
    bf16_t* O; const ssq_t* SS;
    __device__ __forceinline__ void operator()(const f32x4 (&acc)[2][2][4][2], const pg8::Unit& u, int wr, int wc, int fr, int fq) const {
        const int row0 = u.pm * 256 + wr * 64 + fr, col0 = u.pn * 128 + wc * 32 + 8 * fq;
#pragma unroll
        for (int ai = 0; ai < 2; ++ai)
#pragma unroll
            for (int m = 0; m < 4; ++m) { const int r = row0 + ai * 128 + m * 16; const float rs = rstd_of(SS, r); bf16_t* rowp = O + (size_t)r * FH + col0;
                const f32x4 g0 = acc[ai][0][m][0] * rs, g1 = acc[ai][0][m][1] * rs, u0 = acc[ai][1][m][0] * rs, u1 = acc[ai][1][m][1] * rs;
                float h[8];
#pragma unroll
                for (int j = 0; j < 4; ++j) { h[j] = silu_f(g0[j]) * u0[j]; h[4 + j] = silu_f(g1[j]) * u1[j]; }
                *(u32x4*)rowp = PACK8(h); }
    }
};
struct EpiProjCD {
    static constexpr bool PERM = true, AFTER_DRAIN = false;
    bf16_t* O; float* out; const ssq_t* SS; float* DT;
    __device__ __forceinline__ void operator()(const f32x4 (&acc)[2][2][4][2], const pg8::Unit& u, int wr, int wc, int fr, int fq) const {
        const int row0 = u.pm * 256 + wr * 64 + fr, col0 = u.pn * 256 + wc * 32 + 8 * fq;
        if (u.pn == 12) {
            if (wc == 0 && fq == 0) {
#pragma unroll
                for (int ai = 0; ai < 2; ++ai)
#pragma unroll
                    for (int m = 0; m < 4; ++m) { const int r = row0 + ai * 128 + m * 16; const float rs = rstd_of(SS, r); *(f32x4*)(DT + (size_t)r * 8) = acc[ai][0][m][0] * rs; *(f32x4*)(DT + (size_t)r * 8 + 4) = acc[ai][0][m][1] * rs; } }
            return; }
        const int pmb = u.pm & 15;
        const bool kv = (u.pn >= 2 && u.pn < 6) && (pmb >= 14), cvd = (u.pn >= 8) && (pmb == 15);
#pragma unroll
        for (int ai = 0; ai < 2; ++ai)
#pragma unroll
            for (int m = 0; m < 4; ++m) { const int r = row0 + ai * 128 + m * 16; const float rs = rstd_of(SS, r); bf16_t* rowp = O + (size_t)r * NCD + col0;
#pragma unroll
                for (int bj = 0; bj < 2; ++bj) { const f32x4 v0 = acc[ai][bj][m][0] * rs, v1 = acc[ai][bj][m][1] * rs;
                    *(u32x4*)(rowp + bj * 128) = (u32x4){pk2(v0[0], v0[1]), pk2(v0[2], v0[3]), pk2(v1[0], v1[1]), pk2(v1[2], v1[3])};
                    if (kv) { const int c = col0 + bj * 128; const bool isv = c >= 1024; const int cc = c - (isv ? 1024 : 512);
                        const int b = r >> 12, t = r & 4095; float* o = out + (isv ? O_VC_P : O_KC_P) + ((size_t)b * 512 + (t - 3584)) * 512 + cc;
                        *(f32x4*)o = v0; *(f32x4*)(o + 4) = v1; }
                    if (cvd) { const int cc = col0 + bj * 128 - 2048; const int b = r >> 12, t = r & 4095;
                        if (t >= 4093) { float* o = out + O_CONVD_P + ((size_t)b * 3 + (t - 4093)) * 1024 + cc; *(f32x4*)o = v0; *(f32x4*)(o + 4) = v1; } } } }
    }
};

template <class Epi> __device__ __forceinline__ void run_gemm(unsigned char* lds, const bf16_t* A, const bf16_t* Bt, int N, int K, const Epi& E, int stagger = 0) {
    if (stagger > 0) { const unsigned long long t0 = __builtin_amdgcn_s_memrealtime(); const unsigned long long off = ((unsigned long long)(__brev((unsigned)blockIdx.x) >> 24) * (unsigned)stagger) >> 8;
        while (__builtin_amdgcn_s_memrealtime() - t0 < off) __builtin_amdgcn_s_sleep(8); }
    pg8::Gemm g{A, Bt, MP, N, K}; pg8::StaticOrder S; S.init(MP, N, (int)gridDim.x, (int)blockIdx.x);
    pg8::gemm_phase<Epi, pg8::StaticOrder, false>((PG8_LAS unsigned char*)lds, g, S, E, nullptr);
}


#ifndef SMALL_REP
#define SMALL_REP 1
#endif
template <int MODE>
__device__ __forceinline__ void small_gemm(const Params& p, unsigned char* lds, const bf16_t* __restrict__ A, const bf16_t* __restrict__ Bt, int K, int nct, const ssq_t* SS, bf16_t* HB, const float* Rf, ssq_t* SSo) {
    const int tid = ltid(), wid = tid >> 6, lane = tid & 63, fr = lane & 15, G = lane >> 4, wr = wid >> 1, wc = wid & 1;
    bf16_t* PROJ = (bf16_t*)(p.ws + WS_PROJ);
    unsigned char* As = lds; unsigned char* Bs = lds + 65536;
    const int nchunk = (K + 511) >> 9;
    for (int rr = 0; rr < ((MODE == 1) ? 1 : SMALL_REP); ++rr)
    for (int u = blockIdx.x; u < 64 * ((nct + 7) >> 3); u += gridDim.x) {
        const int rt = (u >> 3) & 7, ct = (u & 7) + 8 * (u >> 6);
        if (ct >= nct) continue;
        const int srow = tid >> 6, sgran = tid & 63;
        const bf16_t* ag = A + (size_t)(MP + rt * 64 + srow) * K + sgran * 8;
        size_t bgo[8];
#pragma unroll
        for (int j2 = 0; j2 < 8; ++j2) { const int i = srow + 8 * j2; int brow;
            if (MODE == 2) { const int hc = ct * 32 + (i >> 5) * 16 + (i & 15); brow = 256 * (hc >> 7) + (hc & 127) + 128 * ((i >> 4) & 1); } else brow = ct * 64 + i;
            bgo[j2] = (size_t)brow * K + sgran * 8; }
        u32x4 ra[8], rb[8];
#define SG_LOAD(kc) do { const bool okk = (kc) + sgran * 8 < K; _Pragma("unroll") for (int j2 = 0; j2 < 8; ++j2) { if (okk) { ra[j2] = *(const u32x4*)(ag + (size_t)(8 * j2) * K + (kc)); rb[j2] = *(const u32x4*)(Bt + bgo[j2] + (kc)); } } } while (0)
        SG_LOAD(0);
        f32x4 acc0 = (f32x4){0.f, 0.f, 0.f, 0.f}, acc1 = (f32x4){0.f, 0.f, 0.f, 0.f};
        for (int c = 0; c < nchunk; ++c) {
            const int kc = c << 9;
#pragma unroll
            for (int j2 = 0; j2 < 8; ++j2) { const int row = srow + 8 * j2; const int off = row * 1024 + ((sgran ^ (row & 7)) << 4); *(u32x4*)(As + off) = ra[j2]; *(u32x4*)(Bs + off) = rb[j2]; }
            __syncthreads();
            if (c + 1 < nchunk) SG_LOAD(kc + 512);
            const int nks = (K - kc >= 512) ? 16 : ((K - kc) >> 5);
            const int arow = wr * 16 + fr, brow0 = wc * 32 + fr, brow1 = brow0 + 16;
            for (int ks = 0; ks < nks; ++ks) { const int gran = ks * 4 + G;
                const bf16x8 av = *(const bf16x8*)(As + arow * 1024 + ((gran ^ (arow & 7)) << 4));
                const bf16x8 w0 = *(const bf16x8*)(Bs + brow0 * 1024 + ((gran ^ (brow0 & 7)) << 4)), w1 = *(const bf16x8*)(Bs + brow1 * 1024 + ((gran ^ (brow1 & 7)) << 4));
                acc0 = MFMA16(w0, av, acc0); acc1 = MFMA16(w1, av, acc1); }
            __syncthreads();
        }
#undef SG_LOAD
        const int row = rt * 64 + wr * 16 + fr;
        const size_t grow = (size_t)MP + row;
        if (MODE == 0) { const float rs = rstd_of(SS, (int)grow);
#pragma unroll
            for (int nt = 0; nt < 2; ++nt) { const int col = ct * 64 + wc * 32 + nt * 16 + 4 * G; f32x4 v = (nt ? acc1 : acc0) * rs;
                if (col >= 1536) { const f32x2 a = pg8::gelu_pk((f32x2){v[0], v[1]}), b = pg8::gelu_pk((f32x2){v[2], v[3]}); v = (f32x4){a.x, a.y, b.x, b.y}; }
                *(u32x2*)(PROJ + grow * NAB + col) = (u32x2){pk2(v[0], v[1]), pk2(v[2], v[3])}; }
        } else if (MODE == 1) { float ss = 0.f;
#pragma unroll
            for (int nt = 0; nt < 2; ++nt) { const int col = ct * 64 + wc * 32 + nt * 16 + 4 * G; f32x4 v = nt ? acc1 : acc0;
                if (Rf) v += *(const f32x4*)(Rf + (size_t)row * DM + col);
                else { const u32x2 hv = *(const u32x2*)(HB + grow * DM + col); v += (f32x4){bflo(hv[0]), bfhi(hv[0]), bflo(hv[1]), bfhi(hv[1])}; }
                ss += v[0] * v[0] + v[1] * v[1] + v[2] * v[2] + v[3] * v[3];
                *(u32x2*)(HB + grow * DM + col) = (u32x2){pk2(v[0], v[1]), pk2(v[2], v[3])}; }
            ss += __shfl_xor(ss, 16); ss += __shfl_xor(ss, 32);
            if (G == 0) atomicAdd(SSo + grow, ssq_fix(ss));
        } else if (MODE == 2) { const float rs = rstd_of(SS, (int)grow);
            const int col = ct * 32 + wc * 16 + 4 * G; const f32x4 g = acc0 * rs, uu = acc1 * rs;
            *(u32x2*)(PROJ + grow * FH + col) = (u32x2){pk2(silu_f(g[0]) * uu[0], silu_f(g[1]) * uu[1]), pk2(silu_f(g[2]) * uu[2], silu_f(g[3]) * uu[3])};
        } else { const float rs = rstd_of(SS, (int)grow);
#pragma unroll
            for (int nt = 0; nt < 2; ++nt) { const int col = ct * 64 + wc * 32 + nt * 16 + 4 * G; const f32x4 v = (nt ? acc1 : acc0) * rs;
                if (col >= NCD) { if (col < NCD + 8) *(f32x4*)((float*)(p.ws + WS_DT) + grow * 8 + (col - NCD)) = v; continue; }
                *(u32x2*)(PROJ + grow * NCD + col) = (u32x2){pk2(v[0], v[1]), pk2(v[2], v[3])};
                if (col >= 512 && col < 1536) { const bool isv = col >= 1024; *(f32x4*)(p.out + (isv ? O_VC_S : O_KC_S) + (size_t)row * 512 + (col - (isv ? 1024 : 512))) = v; }
                if (col >= 2048) { const int sb = row >> 6, t = row & 63; if (t >= 61) *(f32x4*)(p.out + O_CONVD_S + ((size_t)sb * 3 + (t - 61)) * 1024 + (col - 2048)) = v; } }
        }
    }
}

struct WtJob { const float* src; const float* gk; bf16_t* dst; int ld, col0, k0, drow0, Kd; };
__device__ __forceinline__ WtJob wt_decode(const Params& p, int t) {
    WtJob J; int q = t;
    if (q < 640) { const int nt = q >> 4, kt = q & 15; J = WtJob{p.w_in_ab, p.norm_mix, (bf16_t*)(p.ws + WS_WT_INAB), NAB, nt * 64, kt * 64, nt * 64, DM}; return J; } q -= 640;
    if (q < 256) { const int nt = q >> 4, kt = q & 15; J = WtJob{p.w_out_ab, nullptr, (bf16_t*)(p.ws + WS_WT_OUTAB), DM, nt * 64, kt * 64, nt * 64, DM}; return J; } q -= 256;
    if (q < 768) { const int nt = q >> 4, kt = q & 15; J = WtJob{p.w_in_cd, p.norm_mix + DM, (bf16_t*)(p.ws + WS_WT_INCD), NCDF, nt * 64, kt * 64, nt * 64, DM}; return J; } q -= 768;
    if (q < 256) { const int nt = q >> 4, kt = q & 15; J = WtJob{p.w_out_cd, nullptr, (bf16_t*)(p.ws + WS_WT_OUTCD), DM, nt * 64, kt * 64, nt * 64, DM}; return J; } q -= 256;
    if (q < 2816) { const int layer = q / 1408; q -= layer * 1408; const int nt = q >> 4, kt = q & 15, pn = nt >> 2, bj = (nt & 3) >> 1, i0 = (nt & 1) * 64;
        J = WtJob{(bj ? p.w_up : p.w_gate) + (size_t)layer * DM * FH, p.norm_ffn + layer * DM, (bf16_t*)(p.ws + WS_WT_GU) + (size_t)layer * 2 * FH * DM, FH, 128 * pn + i0, kt * 64, nt * 64, DM}; return J; } q -= 2816;
    { const int layer = q / 704; q -= layer * 704; const int nt = q / 44, kt = q - nt * 44;
        J = WtJob{p.w_down + (size_t)layer * FH * DM, nullptr, (bf16_t*)(p.ws + WS_WT_DN) + (size_t)layer * DM * FH, DM, nt * 64, kt * 64, nt * 64, FH}; }
    return J;
}
__device__ __forceinline__ void wt_load(const WtJob& J, int tid, float4 (&v)[2], float (&gs)[2]) {
#pragma unroll
    for (int i = 0; i < 2; ++i) { const int k = (tid >> 4) + 32 * i, n4 = (tid & 15) * 4;
        v[i] = *(const float4*)(J.src + (size_t)(J.k0 + k) * J.ld + J.col0 + n4); gs[i] = J.gk ? J.gk[J.k0 + k] : 1.f; }
}
__device__ __forceinline__ void phase_prep(const Params& p, unsigned char* lds) {
    float* tl = (float*)lds; const int tid = ltid();
    { int t = blockIdx.x; WtJob J = wt_decode(p, t < 6144 ? t : 0); float4 v[2]; float gs[2]; wt_load(J, tid, v, gs);
      for (; t < 6144; t += gridDim.x) {
#pragma unroll
          for (int i = 0; i < 2; ++i) { const int k = (tid >> 4) + 32 * i, n4 = (tid & 15) * 4;
              tl[k * 65 + n4] = v[i].x * gs[i]; tl[k * 65 + n4 + 1] = v[i].y * gs[i]; tl[k * 65 + n4 + 2] = v[i].z * gs[i]; tl[k * 65 + n4 + 3] = v[i].w * gs[i]; }
          __syncthreads();
          const int tn = t + (int)gridDim.x; const WtJob Jn = wt_decode(p, tn < 6144 ? tn : t);
          wt_load(Jn, tid, v, gs);
          { const int n = tid >> 3, k8 = (tid & 7) * 8; float f[8];
#pragma unroll
            for (int i = 0; i < 8; ++i) f[i] = tl[(k8 + i) * 65 + n];
            *(u32x4*)(J.dst + (size_t)(J.drow0 + n) * J.Kd + J.k0 + k8) = PACK8(f); }
          __syncthreads();
          J = Jn; } }
    { bf16_t* W = (bf16_t*)(p.ws + WS_WT_INCD);
      for (int i = blockIdx.x * 512 + ltid(); i < 256 * DM; i += gridDim.x * 512) { const int n = i >> 10, k = i & 1023;
          W[(size_t)(NCD + n) * DM + k] = n < 8 ? f2bf(p.w_in_cd[(size_t)k * NCDF + NCD + n] * p.norm_mix[DM + k]) : (bf16_t)0; } }
    { ssq_t* SS = (ssq_t*)(p.ws + WS_SS); for (int i = blockIdx.x * 512 + ltid(); i < 4 * MT; i += gridDim.x * 512) SS[MT + i] = 0ull; }
    { bf16_t* HD = (bf16_t*)(p.ws + WS_HD); for (int i = blockIdx.x * 512 + ltid(); i < 25 * 1024; i += gridDim.x * 512) HD[i] = i < 24 * 1024 ? f2bf(p.state_conv_d[i]) : (bf16_t)0; }
    { bf16_t* WB = (bf16_t*)(p.ws + WS_WSB); for (int i = blockIdx.x * 512 + ltid(); i < 4 * 128 * 128; i += gridDim.x * 512) { const int t = (i >> 7) & 127, sc = i & 127; WB[i] = sc <= t ? f2bf(p.w_s_b[i]) : (bf16_t)0; } }
    { const size_t n8 = (size_t)8 * 512 * 512 / 8; bf16_t* CK = (bf16_t*)(p.ws + WS_CK); bf16_t* CV = (bf16_t*)(p.ws + WS_CV);
      for (size_t i = (size_t)blockIdx.x * 512 + ltid(); i < 2 * n8; i += (size_t)gridDim.x * 512) {
          const bool isv = i >= n8; const size_t e = (isv ? i - n8 : i) * 8; const float* s = (isv ? p.cache_v : p.cache_k) + e;
          const float4 a = *(const float4*)s, b = *(const float4*)(s + 4);
          *(u32x4*)((isv ? CV : CK) + e) = (u32x4){pk2(a.x, a.y), pk2(a.z, a.w), pk2(b.x, b.y), pk2(b.z, b.w)}; } }
}

__device__ __forceinline__ void phase_convert_x(const Params& p) {
    const int tid = ltid(), wid = tid >> 6, lane = tid & 63;
    bf16_t* HB = (bf16_t*)(p.ws + WS_XN); ssq_t* SS = (ssq_t*)(p.ws + WS_SS);
    const int stride = gridDim.x * 8;
    for (int row = blockIdx.x * 8 + wid; row < MT; row += 2 * stride) {
        const int row2 = row + stride; const bool has2 = row2 < MT; const int r2 = has2 ? row2 : row;
        const float* s1 = row < MP ? p.x_prompt + (size_t)row * DM : p.x_sample + (size_t)(row - MP) * DM;
        const float* s2 = r2 < MP ? p.x_prompt + (size_t)r2 * DM : p.x_sample + (size_t)(r2 - MP) * DM;
        float4 v1[4], v2[4];
#pragma unroll
        for (int i = 0; i < 4; ++i) { v1[i] = *(const float4*)(s1 + i * 256 + lane * 4); v2[i] = *(const float4*)(s2 + i * 256 + lane * 4); }
        float ss1 = 0.f, ss2 = 0.f;
#pragma unroll
        for (int i = 0; i < 4; ++i) { ss1 += v1[i].x * v1[i].x + v1[i].y * v1[i].y + v1[i].z * v1[i].z + v1[i].w * v1[i].w; ss2 += v2[i].x * v2[i].x + v2[i].y * v2[i].y + v2[i].z * v2[i].z + v2[i].w * v2[i].w;
            *(u32x2*)(HB + (size_t)row * DM + i * 256 + lane * 4) = (u32x2){pk2(v1[i].x, v1[i].y), pk2(v1[i].z, v1[i].w)};
            if (has2) *(u32x2*)(HB + (size_t)row2 * DM + i * 256 + lane * 4) = (u32x2){pk2(v2[i].x, v2[i].y), pk2(v2[i].z, v2[i].w)}; }
        ss1 = wave_sum(ss1); ss2 = wave_sum(ss2);
        if (lane == 0) { SS[row] = ssq_fix(ss1); if (has2) SS[row2] = ssq_fix(ss2); }
    }
}
__device__ __forceinline__ void phase_final_norm(const Params& p) {
    const int tid = ltid(), wid = tid >> 6, lane = tid & 63;
    const bf16_t* HB = (const bf16_t*)(p.ws + WS_XN); const ssq_t* SS = (const ssq_t*)(p.ws + WS_SS) + (size_t)4 * MT;
    float4 gv[4];
#pragma unroll
    for (int i = 0; i < 4; ++i) gv[i] = *(const float4*)(p.norm_final + i * 256 + lane * 4);
    for (int row = blockIdx.x * 8 + wid; row < MT; row += gridDim.x * 8) {
        const float rstd = rstd_of(SS, row); float* o = p.out + (size_t)row * DM;
#pragma unroll
        for (int i = 0; i < 4; ++i) { const u32x2 hv = *(const u32x2*)(HB + (size_t)row * DM + i * 256 + lane * 4);
            *(float4*)(o + i * 256 + lane * 4) = make_float4(bflo(hv[0]) * rstd * gv[i].x, bfhi(hv[0]) * rstd * gv[i].y, bflo(hv[1]) * rstd * gv[i].z, bfhi(hv[1]) * rstd * gv[i].w); }
    }
}

__device__ __forceinline__ void phase_mixer_ab(const Params& p, unsigned char* lds) {
    const int tid = ltid(), wid = tid >> 6, lane = tid & 63, fr = lane & 15, G = lane >> 4;
    const bf16_t* PROJ = (const bf16_t*)(p.ws + WS_PROJ); bf16_t* MIX = (bf16_t*)(p.ws + WS_MIX);
    bf16_t* VT = (bf16_t*)lds;
    const bf16_t* WSB = (const bf16_t*)(p.ws + WS_WSB);
    for (int u = blockIdx.x; u < 520; u += gridDim.x) {
        const bool smp = u >= 512; const int b = smp ? u - 512 : (u >> 5), blk = smp ? 0 : (u & 31);
        const int L = smp ? 64 : 128, rpw = L >> 3, t0 = wid * rpw;
        const size_t row0 = smp ? (size_t)MP + (size_t)b * 64 : (size_t)b * 4096 + (size_t)blk * 128;
        { const int c8 = lane * 8; float w0[8], w1[8], w2[8], um2[8], um1[8];
          { const float4 a0 = *(const float4*)(p.conv_w_a + c8), a1 = *(const float4*)(p.conv_w_a + c8 + 4), b0 = *(const float4*)(p.conv_w_a + 512 + c8), b1 = *(const float4*)(p.conv_w_a + 512 + c8 + 4),
                c0 = *(const float4*)(p.conv_w_a + 1024 + c8), c1 = *(const float4*)(p.conv_w_a + 1024 + c8 + 4);
            w0[0] = a0.x; w0[1] = a0.y; w0[2] = a0.z; w0[3] = a0.w; w0[4] = a1.x; w0[5] = a1.y; w0[6] = a1.z; w0[7] = a1.w;
            w1[0] = b0.x; w1[1] = b0.y; w1[2] = b0.z; w1[3] = b0.w; w1[4] = b1.x; w1[5] = b1.y; w1[6] = b1.z; w1[7] = b1.w;
            w2[0] = c0.x; w2[1] = c0.y; w2[2] = c0.z; w2[3] = c0.w; w2[4] = c1.x; w2[5] = c1.y; w2[6] = c1.z; w2[7] = c1.w; }
          const int tg = blk * 128 + t0;
          if (tg > 0) {
              const bf16_t* p2 = PROJ + (row0 + t0 - 2) * NAB; const bf16_t* p1 = PROJ + (row0 + t0 - 1) * NAB;
              const u32x4 xa2 = *(const u32x4*)(p2 + c8), gc2 = *(const u32x4*)(p2 + 1024 + c8), xa1 = *(const u32x4*)(p1 + c8), gc1 = *(const u32x4*)(p1 + 1024 + c8);
              float fa[8], fb[8]; UNPACK8(xa2, fa); UNPACK8(gc2, fb);
#pragma unroll
              for (int k = 0; k < 8; ++k) um2[k] = fa[k] * fb[k];
              UNPACK8(xa1, fa); UNPACK8(gc1, fb);
#pragma unroll
              for (int k = 0; k < 8; ++k) um1[k] = fa[k] * fb[k];
          } else if (smp) {
              const float* h0 = p.state_conv_a + ((size_t)b * 2) * 512 + c8; const float4 a0 = *(const float4*)h0, a1 = *(const float4*)(h0 + 4), b0 = *(const float4*)(h0 + 512), b1 = *(const float4*)(h0 + 516);
              um2[0] = a0.x; um2[1] = a0.y; um2[2] = a0.z; um2[3] = a0.w; um2[4] = a1.x; um2[5] = a1.y; um2[6] = a1.z; um2[7] = a1.w;
              um1[0] = b0.x; um1[1] = b0.y; um1[2] = b0.z; um1[3] = b0.w; um1[4] = b1.x; um1[5] = b1.y; um1[6] = b1.z; um1[7] = b1.w;
          } else {
#pragma unroll
              for (int k = 0; k < 8; ++k) { um2[k] = 0.f; um1[k] = 0.f; }
          }
#define MXA_LOAD(X, GB, GC, ib) do { _Pragma("unroll") for (int i = 0; i < 4; ++i) { const bf16_t* pr = PROJ + (row0 + t0 + (ib) + i) * NAB; X[i] = *(const u32x4*)(pr + c8); GB[i] = *(const u32x4*)(pr + 512 + c8); GC[i] = *(const u32x4*)(pr + 1024 + c8); } } while (0)
#define MXA_COMP(X, GB, GC, ib) do { _Pragma("unroll") for (int i = 0; i < 4; ++i) { const int t = t0 + (ib) + i; const size_t r = row0 + t; \
                  float fa[8], fb[8], fc[8], U[8], y[8]; UNPACK8(X[i], fa); UNPACK8(GB[i], fb); UNPACK8(GC[i], fc); \
                  _Pragma("unroll") for (int k = 0; k < 8; ++k) { U[k] = fc[k] * fa[k]; y[k] = fb[k] * (w0[k] * um2[k] + w1[k] * um1[k] + w2[k] * U[k]); } \
                  *(u32x4*)(MIX + r * DM + c8) = PACK8(y); \
                  if (t >= L - 2 && (smp || blk == 31)) { float* o = p.out + (smp ? O_CONVA_S : O_CONVA_P) + ((size_t)b * 2 + (t - (L - 2))) * 512 + c8; \
                      *(float4*)o = make_float4(U[0], U[1], U[2], U[3]); *(float4*)(o + 4) = make_float4(U[4], U[5], U[6], U[7]); } \
                  _Pragma("unroll") for (int k = 0; k < 8; ++k) { um2[k] = um1[k]; um1[k] = U[k]; } } } while (0)
          u32x4 xaA[4], gbA[4], gcA[4], xaB[4], gbB[4], gcB[4];
          MXA_LOAD(xaA, gbA, gcA, 0);
          for (int i0 = 0; i0 < rpw; i0 += 8) {
              MXA_LOAD(xaB, gbB, gcB, i0 + 4);
              MXA_COMP(xaA, gbA, gcA, i0);
              { const int ib = i0 + 8 < rpw ? i0 + 8 : i0; MXA_LOAD(xaA, gbA, gcA, ib); }
              MXA_COMP(xaB, gbB, gcB, i0 + 4); }
#undef MXA_LOAD
#undef MXA_COMP
        }
        for (int i0 = 0; i0 < rpw; i0 += 8) {
            u32x4 vv8[8];
#pragma unroll
            for (int i = 0; i < 8; ++i) vv8[i] = *(const u32x4*)(PROJ + (row0 + t0 + i0 + i) * NAB + 2048 + lane * 8);
            float g8[8], b8[8], ovp[8]; unsigned pkv[8][4];
            { const float4 a = *(const float4*)(p.ln_g_b + lane * 8), bq = *(const float4*)(p.ln_g_b + lane * 8 + 4), c = *(const float4*)(p.ln_b_b + lane * 8), d = *(const float4*)(p.ln_b_b + lane * 8 + 4);
              g8[0] = a.x; g8[1] = a.y; g8[2] = a.z; g8[3] = a.w; g8[4] = bq.x; g8[5] = bq.y; g8[6] = bq.z; g8[7] = bq.w; b8[0] = c.x; b8[1] = c.y; b8[2] = c.z; b8[3] = c.w; b8[4] = d.x; b8[5] = d.y; b8[6] = d.z; b8[7] = d.w; }
#pragma unroll
            for (int i = 0; i < 8; ++i) { const int t = t0 + i0 + i; const size_t r = row0 + t; float f[8]; UNPACK8(vv8[i], f);
                float sm = 0.f;
#pragma unroll
                for (int k = 0; k < 8; ++k) sm += f[k];
                sm = wave_sum(sm); const float mean = sm * (1.f / 512.f); float q = 0.f;
#pragma unroll
                for (int k = 0; k < 8; ++k) { const float dd = f[k] - mean; q += dd * dd; }
                q = wave_sum(q); const float rstd = rsqrtf(q * (1.f / 512.f) + 1e-5f);
                float o8[8];
#pragma unroll
                for (int k = 0; k < 8; ++k) { o8[k] = (f[k] - mean) * rstd * g8[k] + b8[k]; if (i & 1) pkv[k][i >> 1] = pk2(ovp[k], o8[k]); else ovp[k] = o8[k]; }
                if (smp) { float* o = p.out + O_VB_S + (r - MP) * 512 + lane * 8; *(float4*)o = make_float4(o8[0], o8[1], o8[2], o8[3]); *(float4*)(o + 4) = make_float4(o8[4], o8[5], o8[6], o8[7]); } }
#pragma unroll
            for (int k = 0; k < 8; ++k) { const int c = lane * 8 + k; *(u32x4*)(VT + c * 128 + swzv(c, t0 + i0)) = (u32x4){pkv[k][0], pkv[k][1], pkv[k][2], pkv[k][3]}; } }
        __syncthreads();
        if (wid < (L >> 4)) {
            const int t = 16 * wid + fr; const size_t r = row0 + t; const int nks = (16 * (wid + 1) + 31) >> 5;
            for (int g = 0; g < 4; ++g) {
                f32x4 acc[8];
#pragma unroll
                for (int ct = 0; ct < 8; ++ct) acc[ct] = (f32x4){0.f, 0.f, 0.f, 0.f};
                for (int ks = 0; ks < nks; ++ks) { const bf16x8 bw = *(const bf16x8*)(WSB + ((size_t)g * 128 + t) * 128 + 32 * ks + 8 * G);
#pragma unroll
                    for (int ct = 0; ct < 8; ++ct) { const int c = g * 128 + 16 * ct + fr; const bf16x8 av = *(const bf16x8*)(VT + c * 128 + swzv(c, 32 * ks + 8 * G)); acc[ct] = MFMA16(av, bw, acc[ct]); } }
                const float bs = p.b_s_b[g * 128 + t];
#pragma unroll
                for (int ct = 0; ct < 8; ++ct) { const int c = 16 * ct + 4 * G; const u32x2 uu = *(const u32x2*)(PROJ + r * NAB + 1536 + g * 128 + c);
                    const float y0 = bflo(uu[0]) * (acc[ct][0] + bs), y1 = bfhi(uu[0]) * (acc[ct][1] + bs), y2 = bflo(uu[1]) * (acc[ct][2] + bs), y3 = bfhi(uu[1]) * (acc[ct][3] + bs);
                    *(u32x2*)(MIX + r * DM + 512 + g * 128 + c) = (u32x2){pk2(y0, y1), pk2(y2, y3)}; }
            }
        }
        __syncthreads();
    }
}

constexpr int N_ATT_P = 2048, N_ATT = N_ATT_P + 64;
__device__ __forceinline__ void att_unit(const Params& p, unsigned char* lds, int v) {
    const int tid = ltid(), wid = tid >> 6, lane = tid & 63, fr = lane & 15, G = lane >> 4;
    const bf16_t* PROJ = (const bf16_t*)(p.ws + WS_PROJ); bf16_t* MIX = (bf16_t*)(p.ws + WS_MIX);
    const bf16_t* CK = (const bf16_t*)(p.ws + WS_CK); const bf16_t* CV = (const bf16_t*)(p.ws + WS_CV);
    float* tab = (float*)lds; bf16_t* KSB = (bf16_t*)(lds + 1040);
    const bool smp = v >= N_ATT_P; int b, h, c0, jlo, jhi;
    if (!smp) { b = v >> 7; h = (v >> 4) & 7; c0 = 4 * (v & 15); jlo = c0 - 8 > 0 ? c0 - 8 : 0; jhi = c0 + 3; }
    else { const int sv = v - N_ATT_P; b = sv >> 3; h = sv & 7; c0 = 8; jlo = 0; jhi = 8; }
    const int cq = c0 + (wid >> 1), qh = wid & 1; const bool wact = !smp || wid < 2;
    const size_t qrow0 = (smp ? (size_t)MP + (size_t)b * 64 : (size_t)b * 4096 + (size_t)cq * 64) + qh * 32 + fr;
    for (int i = tid; i < 257; i += 512) tab[i] = p.rel_bias_c[h * 257 + i] * 1.44269504089f;
    const float tb_far = p.rel_bias_c[h * 257 + 256] * 1.44269504089f;
    bf16x8 qf[2][2];
#pragma unroll
    for (int qi = 0; qi < 2; ++qi)
#pragma unroll
        for (int ks = 0; ks < 2; ++ks) qf[qi][ks] = wact ? *(const bf16x8*)(PROJ + (qrow0 + 16 * qi) * NCD + h * 64 + 32 * ks + 8 * G) : (bf16x8){0, 0, 0, 0, 0, 0, 0, 0};
    const int skey = tid >> 3, sd8 = (tid & 7) * 8;
    u32x4 krr[4], vrr[4];
#define ATT_LOAD(j, kr, vr) do { const int jj_ = (j) < jhi ? (j) : jhi; const bool fromP = !smp || jj_ == 8; \
        const size_t rrP = (smp ? (size_t)MP + (size_t)b * 64 : (size_t)b * 4096 + (size_t)jj_ * 64) + skey; const size_t offC = ((size_t)b * 512 + (size_t)(jj_ & 7) * 64 + skey) * 512 + h * 64 + sd8; \
        const bf16_t* kp_ = fromP ? PROJ + rrP * NCD + 512 + h * 64 + sd8 : CK + offC; const bf16_t* vp_ = fromP ? PROJ + rrP * NCD + 1024 + h * 64 + sd8 : CV + offC; \
        kr = *(const u32x4*)kp_; vr = *(const u32x4*)vp_; } while (0)
#pragma unroll
    for (int s_ = 0; s_ < 4; ++s_) ATT_LOAD(jlo + s_, krr[s_], vrr[s_]);
    float m[2] = {-1e30f, -1e30f}, lsum[2] = {0.f, 0.f}; f32x4 O[2][4];
#pragma unroll
    for (int qi = 0; qi < 2; ++qi)
#pragma unroll
        for (int dt = 0; dt < 4; ++dt) O[qi][dt] = (f32x4){0.f, 0.f, 0.f, 0.f};
    for (int jb = jlo; jb <= jhi; jb += 4) {
#pragma unroll
      for (int s_ = 0; s_ < 4; ++s_) { const int j = jb + s_; if (j <= jhi) {
        bf16_t* KS = KSB + s_ * 9216; bf16_t* VTt = KS + 4608;
        if ((s_ & 1) == 0) {
#pragma unroll
            for (int q_ = 0; q_ < 2; ++q_) { bf16_t* KSq = KSB + ((s_ + q_) & 3) * 9216; bf16_t* VTq = KSq + 4608;
                *(u32x4*)(KSq + skey * 72 + sd8) = krr[(s_ + q_) & 3];
#pragma unroll
                for (int k = 0; k < 8; ++k) VTq[(sd8 + k) * 72 + swz8(sd8 + k, skey)] = (unsigned short)((k & 1) ? (vrr[(s_ + q_) & 3][k >> 1] >> 16) : (vrr[(s_ + q_) & 3][k >> 1] & 0xffffu)); }
            __syncthreads();
            ATT_LOAD(j + 4, krr[s_], vrr[s_]); ATT_LOAD(j + 5, krr[(s_ + 1) & 3], vrr[(s_ + 1) & 3]);
        }
        if (wact && j >= cq - 8 && j <= cq) {
            f32x4 s[2][4];
#pragma unroll
            for (int kt = 0; kt < 4; ++kt) { s[0][kt] = (f32x4){0.f, 0.f, 0.f, 0.f}; s[1][kt] = (f32x4){0.f, 0.f, 0.f, 0.f};
#pragma unroll
                for (int ks = 0; ks < 2; ++ks) { const bf16x8 a = *(const bf16x8*)(KS + (16 * kt + fr) * 72 + 32 * ks + 8 * G); s[0][kt] = MFMA16(a, qf[0][ks], s[0][kt]); s[1][kt] = MFMA16(a, qf[1][ks], s[1][kt]); } }
            bf16x8 pb[2][2];
#pragma unroll
            for (int qi = 0; qi < 2; ++qi) {
                const int rel0 = (cq * 64 + qh * 32 + qi * 16 + fr) - (j * 64 + 4 * G);
                float mx = -1e30f;
                if (cq - j >= 3) {
#pragma unroll
                    for (int kt = 0; kt < 4; ++kt)
#pragma unroll
                        for (int r = 0; r < 4; ++r) { const float sv = s[qi][kt][r] * (0.125f * 1.44269504089f) + tb_far; s[qi][kt][r] = sv; mx = fmaxf(mx, sv); }
                } else {
#pragma unroll
                    for (int kt = 0; kt < 4; ++kt)
#pragma unroll
                        for (int r = 0; r < 4; ++r) { int rel = rel0 - 16 * kt - r; rel = rel < -128 ? -128 : (rel > 128 ? 128 : rel); const float sv = s[qi][kt][r] * (0.125f * 1.44269504089f) + tab[rel + 128]; s[qi][kt][r] = sv; mx = fmaxf(mx, sv); }
                }
                mx = fmaxf(mx, __shfl_xor(mx, 16)); mx = fmaxf(mx, __shfl_xor(mx, 32));
                const float mnew = fmaxf(m[qi], mx), alpha = __builtin_amdgcn_exp2f(m[qi] - mnew); m[qi] = mnew;
                float ps = 0.f;
#pragma unroll
                for (int kt = 0; kt < 4; ++kt)
#pragma unroll
                    for (int r = 0; r < 4; ++r) { const float e = __builtin_amdgcn_exp2f(s[qi][kt][r] - mnew); s[qi][kt][r] = e; ps += e; }
                lsum[qi] = lsum[qi] * alpha + ps;
#pragma unroll
                for (int dt = 0; dt < 4; ++dt) O[qi][dt] = O[qi][dt] * alpha;
#pragma unroll
                for (int kk = 0; kk < 2; ++kk)
                    pb[qi][kk] = as_bf16x8((u32x4){pk2(s[qi][2 * kk][0], s[qi][2 * kk][1]), pk2(s[qi][2 * kk][2], s[qi][2 * kk][3]), pk2(s[qi][2 * kk + 1][0], s[qi][2 * kk + 1][1]), pk2(s[qi][2 * kk + 1][2], s[qi][2 * kk + 1][3])});
            }
#pragma unroll
            for (int kk = 0; kk < 2; ++kk)
#pragma unroll
                for (int dt = 0; dt < 4; ++dt) { const bf16_t* vrow = VTt + (16 * dt + fr) * 72; const u32x2 v0 = *(const u32x2*)(vrow + swz8(16 * dt + fr, 32 * kk + 4 * G)), v1 = *(const u32x2*)(vrow + swz8(16 * dt + fr, 32 * kk + 16 + 4 * G));
                    const bf16x8 av = as_bf16x8((u32x4){v0[0], v0[1], v1[0], v1[1]});
                    O[0][dt] = MFMA16(av, pb[0][kk], O[0][dt]); O[1][dt] = MFMA16(av, pb[1][kk], O[1][dt]); }
        }
      } }
    }
#undef ATT_LOAD
    if (wact) {
#pragma unroll
        for (int qi = 0; qi < 2; ++qi) { float ls = lsum[qi]; ls += __shfl_xor(ls, 16); ls += __shfl_xor(ls, 32); const float inv = 1.f / ls;
#pragma unroll
            for (int dt = 0; dt < 4; ++dt) *(u32x2*)(MIX + (qrow0 + 16 * qi) * DM + h * 64 + 16 * dt + 4 * G) = (u32x2){pk2(O[qi][dt][0] * inv, O[qi][dt][1] * inv), pk2(O[qi][dt][2] * inv, O[qi][dt][3] * inv)}; }
    }
    __syncthreads();
}

constexpr int N_SSD = 2 * 1032;
constexpr int SL_DT = 0, SL_CUM = 1024, SL_XT = 2048, SL_BN = SL_XT + 4 * 64 * 72 * 2, SL_CN = SL_BN + 64 * 136 * 2, SL_BT = SL_CN + 64 * 136 * 2, SL_CB = SL_BT + 128 * 72 * 2, SL_SS = SL_CB + 64 * 68 * 4, SL_END = SL_SS + 1024;
static_assert(SL_END <= LDS_BYTES, "LDS");
struct SsdUnit { bool smp; int b, c, g, cs; size_t row0; };
__device__ __forceinline__ SsdUnit ssd_decode(int u) { SsdUnit s; s.g = u & 1; const int cs = u >> 1; s.cs = cs; s.smp = cs >= 1024;
    if (s.smp) { s.b = cs - 1024; s.c = 0; s.row0 = (size_t)MP + (size_t)s.b * 64; } else { s.b = cs >> 6; s.c = cs & 63; s.row0 = (size_t)cs * 64; } return s; }

__device__ __forceinline__ void ssd_rows_load(const Params& p, const SsdUnit& U, u32x4 (&rws)[11]) {
    const int tid = ltid(), wid = tid >> 6, lane = tid & 63; const int g = U.g;
    const bf16_t* PROJ = (const bf16_t*)(p.ws + WS_PROJ); const bf16_t* HD = (const bf16_t*)(p.ws + WS_HD);
    const int xc = lane < 32 ? g * 256 + lane * 8 : (lane < 48 ? 512 + g * 128 + (lane - 32) * 8 : 768 + g * 128 + (lane - 48) * 8);
    const int t0 = wid * 8;
#pragma unroll
    for (int k = 0; k < 11; ++k) { const int tt = t0 - 3 + k; const bool inseq = tt >= 0 || (!U.smp && U.c > 0);
        const bf16_t* src = inseq ? PROJ + (size_t)((long)U.row0 + tt) * NCD + 2048 + xc : (U.smp ? HD + (size_t)(U.b * 3 + (tt < 0 ? 3 + tt : 0)) * 1024 + xc : HD + 24 * 1024 + xc);
        rws[k] = *(const u32x4*)src; }
}
template <bool OUTP>
__device__ __forceinline__ void ssd_stage(const Params& p, unsigned char* lds, const SsdUnit& U, const u32x4 (&rws)[11]) {
    const int tid = ltid(), wid = tid >> 6, lane = tid & 63;
    const bf16_t* PROJ = (const bf16_t*)(p.ws + WS_PROJ); const float* DT = (const float*)(p.ws + WS_DT);
    bf16_t* XT = (bf16_t*)(lds + SL_XT); bf16_t* BN = (bf16_t*)(lds + SL_BN); bf16_t* CN = (bf16_t*)(lds + SL_CN); bf16_t* BT = (bf16_t*)(lds + SL_BT);
    float* dtl = (float*)(lds + SL_DT); float* cuml = (float*)(lds + SL_CUM);
    const int g = U.g;
    const int xc = lane < 32 ? g * 256 + lane * 8 : (lane < 48 ? 512 + g * 128 + (lane - 32) * 8 : 768 + g * 128 + (lane - 48) * 8);
    const bool act = OUTP || lane < 48;
    if (act) {
        float cw[4][8], cb[8], win[3][8];
        const int t0 = wid * 8;
#pragma unroll
        for (int k = 0; k < 4; ++k) { const float4 a = *(const float4*)(p.conv_w_d + k * 1024 + xc), bb = *(const float4*)(p.conv_w_d + k * 1024 + xc + 4);
            cw[k][0] = a.x; cw[k][1] = a.y; cw[k][2] = a.z; cw[k][3] = a.w; cw[k][4] = bb.x; cw[k][5] = bb.y; cw[k][6] = bb.z; cw[k][7] = bb.w; }
        { const float4 a = *(const float4*)(p.conv_b_d + xc), bb = *(const float4*)(p.conv_b_d + xc + 4); cb[0] = a.x; cb[1] = a.y; cb[2] = a.z; cb[3] = a.w; cb[4] = bb.x; cb[5] = bb.y; cb[6] = bb.z; cb[7] = bb.w; }
#pragma unroll
        for (int k = 0; k < 3; ++k) UNPACK8(rws[k], win[k]);
        unsigned pkt[8][4]; float oprev[8];
#pragma unroll
        for (int i = 0; i < 8; ++i) { const int t = t0 + i; float cur[8], o[8]; UNPACK8(rws[3 + i], cur);
#pragma unroll
            for (int e = 0; e < 8; ++e) { o[e] = silu_f(cw[0][e] * win[0][e] + cw[1][e] * win[1][e] + cw[2][e] * win[2][e] + cw[3][e] * cur[e] + cb[e]); win[0][e] = win[1][e]; win[1][e] = win[2][e]; win[2][e] = cur[e]; }
            if (OUTP && lane >= 32) { if (lane < 48) *(u32x4*)(BN + t * 136 + (lane - 32) * 8) = PACK8(o); else *(u32x4*)(CN + t * 136 + (lane - 48) * 8) = PACK8(o); }
#pragma unroll
            for (int e = 0; e < 8; ++e) { if (i & 1) pkt[e][i >> 1] = pk2(oprev[e], o[e]); else oprev[e] = o[e]; } }
        if (lane < 32) { const int hh = lane >> 3, pp = (lane & 7) * 8;
#pragma unroll
            for (int e = 0; e < 8; ++e) *(u32x4*)(XT + (hh * 64 + pp + e) * 72 + swz8(pp + e, t0)) = (u32x4){pkt[e][0], pkt[e][1], pkt[e][2], pkt[e][3]}; }
        else if (!OUTP && lane < 48) { const int n = (lane - 32) * 8;
#pragma unroll
            for (int e = 0; e < 8; ++e) *(u32x4*)(BT + (n + e) * 72 + swz8(n + e, t0)) = (u32x4){pkt[e][0], pkt[e][1], pkt[e][2], pkt[e][3]}; }
    }
    if (wid < 4) { const int h = g * 4 + wid; const float x = DT[(U.row0 + lane) * 8 + h] + p.dt_bias_d[h];
        const float dt = fmaxf(x, 0.f) + log1pf(expf(-fabsf(x))); const float A = -expf(p.a_log_d[h]); float a = dt * A;
#pragma unroll
        for (int o = 1; o < 64; o <<= 1) { const float y = __shfl_up(a, o); if (lane >= o) a += y; }
        dtl[wid * 64 + lane] = dt; cuml[wid * 64 + lane] = a; }
}

__device__ __forceinline__ void ssd_state_unit(const Params& p, unsigned char* lds, int u, int unext, u32x4 (&rws)[11]) {
    const int tid = ltid(), wid = tid >> 6, lane = tid & 63, fr = lane & 15, G = lane >> 4;
    const SsdUnit U = ssd_decode(u);
    ssd_stage<false>(p, lds, U, rws);
    ssd_rows_load(p, ssd_decode(unext), rws);
    __syncthreads();
    const bf16_t* XT = (const bf16_t*)(lds + SL_XT); const bf16_t* BT = (const bf16_t*)(lds + SL_BT);
    const float* dtl = (const float*)(lds + SL_DT); const float* cuml = (const float*)(lds + SL_CUM);
    unsigned short* SB = (unsigned short*)(p.ws + WS_SBUF); float* DEC = (float*)(p.ws + WS_DEC);
    const int hh = wid >> 1, half = wid & 1, h = U.g * 4 + hh; const float cumQ = cuml[hh * 64 + 63];
    f32x4 acc[2][8];
#pragma unroll
    for (int pt = 0; pt < 2; ++pt)
#pragma unroll
        for (int nt = 0; nt < 8; ++nt) acc[pt][nt] = (f32x4){0.f, 0.f, 0.f, 0.f};
#pragma unroll
    for (int ks = 0; ks < 2; ++ks) { const int s0 = 32 * ks + 8 * G; float w[8];
        { const float4 d0 = *(const float4*)(dtl + hh * 64 + s0), d1 = *(const float4*)(dtl + hh * 64 + s0 + 4), c0 = *(const float4*)(cuml + hh * 64 + s0), c1 = *(const float4*)(cuml + hh * 64 + s0 + 4);
          w[0] = d0.x * __expf(cumQ - c0.x); w[1] = d0.y * __expf(cumQ - c0.y); w[2] = d0.z * __expf(cumQ - c0.z); w[3] = d0.w * __expf(cumQ - c0.w);
          w[4] = d1.x * __expf(cumQ - c1.x); w[5] = d1.y * __expf(cumQ - c1.y); w[6] = d1.z * __expf(cumQ - c1.z); w[7] = d1.w * __expf(cumQ - c1.w); }
        bf16x8 xb[2];
#pragma unroll
        for (int pt = 0; pt < 2; ++pt) { const u32x4 raw = *(const u32x4*)(XT + (hh * 64 + 32 * half + 16 * pt + fr) * 72 + swz8(32 * half + 16 * pt + fr, s0)); float f[8]; UNPACK8(raw, f);
#pragma unroll
            for (int e = 0; e < 8; ++e) f[e] *= w[e];
            xb[pt] = as_bf16x8(PACK8(f)); }
#pragma unroll
        for (int nt = 0; nt < 8; ++nt) { const bf16x8 a = *(const bf16x8*)(BT + (16 * nt + fr) * 72 + swz8(16 * nt + fr, s0));
#pragma unroll
            for (int pt = 0; pt < 2; ++pt) acc[pt][nt] = MFMA16(a, xb[pt], acc[pt][nt]); } }
#pragma unroll
    for (int pt = 0; pt < 2; ++pt)
#pragma unroll
        for (int nt = 0; nt < 8; ++nt) { const int pp = 32 * half + 16 * pt + fr, n = 16 * nt + 4 * G; *(u32x2*)(SB + (((size_t)U.cs * 8 + h) * 64 + pp) * 128 + n) = (u32x2){pkh2(acc[pt][nt][0], acc[pt][nt][1]), pkh2(acc[pt][nt][2], acc[pt][nt][3])}; }
    if (half == 0 && lane == 0) DEC[U.cs * 8 + h] = expf(cumQ);
    __syncthreads();
}

__device__ __forceinline__ void phase_scan(const Params& p) {
    const unsigned short* SB = (const unsigned short*)(p.ws + WS_SBUF); const float* DEC = (const float*)(p.ws + WS_DEC); bf16_t* HIN = (bf16_t*)p.out;
    for (int e = blockIdx.x * 512 + ltid(); e < 131072 + 65536; e += gridDim.x * 512) {
        if (e < 131072) { const int bb = e >> 13, off = (e & 8191) * 8, h = off >> 13; float hs[8];
#pragma unroll
            for (int k = 0; k < 8; ++k) hs[k] = 0.f;
            for (int c0 = 0; c0 < 64; c0 += 8) { u32x4 sv[8]; float d[8];
#pragma unroll
                for (int i = 0; i < 8; ++i) { const size_t cs = (size_t)bb * 64 + c0 + i; sv[i] = *(const u32x4*)(SB + cs * 65536 + off); d[i] = DEC[cs * 8 + h]; }
#pragma unroll
                for (int i = 0; i < 8; ++i) { const size_t cs = (size_t)bb * 64 + c0 + i; *(u32x4*)(HIN + cs * 65536 + off) = PACK8(hs);
                    hs[0] = d[i] * hs[0] + h16lo(sv[i][0]); hs[1] = d[i] * hs[1] + h16hi(sv[i][0]); hs[2] = d[i] * hs[2] + h16lo(sv[i][1]); hs[3] = d[i] * hs[3] + h16hi(sv[i][1]);
                    hs[4] = d[i] * hs[4] + h16lo(sv[i][2]); hs[5] = d[i] * hs[5] + h16hi(sv[i][2]); hs[6] = d[i] * hs[6] + h16lo(sv[i][3]); hs[7] = d[i] * hs[7] + h16hi(sv[i][3]); } }
            float* o = p.out + O_SSM_P + (size_t)bb * 65536 + off; *(float4*)o = make_float4(hs[0], hs[1], hs[2], hs[3]); *(float4*)(o + 4) = make_float4(hs[4], hs[5], hs[6], hs[7]);
        } else { const int e2 = e - 131072, sb_ = e2 >> 13, off = (e2 & 8191) * 8, h = off >> 13; const size_t cs = 1024 + sb_;
            const float* h0 = p.state_ssm_d + (size_t)sb_ * 65536 + off; const float4 a = *(const float4*)h0, b = *(const float4*)(h0 + 4);
            float hs[8] = {a.x, a.y, a.z, a.w, b.x, b.y, b.z, b.w};
            const u32x4 sv = *(const u32x4*)(SB + cs * 65536 + off); const float d = DEC[cs * 8 + h];
            const float4 sa = make_float4(h16lo(sv[0]), h16hi(sv[0]), h16lo(sv[1]), h16hi(sv[1])), sb = make_float4(h16lo(sv[2]), h16hi(sv[2]), h16lo(sv[3]), h16hi(sv[3]));
            *(u32x4*)(HIN + cs * 65536 + off) = PACK8(hs);
            float* o = p.out + O_SSM_S + (size_t)sb_ * 65536 + off;
            *(float4*)o = make_float4(d * hs[0] + sa.x, d * hs[1] + sa.y, d * hs[2] + sa.z, d * hs[3] + sa.w); *(float4*)(o + 4) = make_float4(d * hs[4] + sb.x, d * hs[5] + sb.y, d * hs[6] + sb.z, d * hs[7] + sb.w); }
    }
}

template <bool PIPE>
__device__ __forceinline__ void ssd_out_unit(const Params& p, unsigned char* lds, int u, int unext, u32x4 (&rws)[11]) {
    const int tid = ltid(), wid = tid >> 6, lane = tid & 63, fr = lane & 15, G = lane >> 4;
    const SsdUnit U = ssd_decode(u);
    if (!PIPE) ssd_rows_load(p, U, rws);
    ssd_stage<true>(p, lds, U, rws);
    if (PIPE) ssd_rows_load(p, ssd_decode(unext), rws);
    bf16x8 hfr[4][4]; u32x2 zpre[2][4];
    { const int hh_ = wid >> 1, half_ = wid & 1, h_ = U.g * 4 + hh_; const bf16_t* hb_ = (const bf16_t*)p.out + ((size_t)U.cs * 8 + h_) * 8192;
#pragma unroll
      for (int ks = 0; ks < 4; ++ks)
#pragma unroll
          for (int pt = 0; pt < 4; ++pt) hfr[ks][pt] = *(const bf16x8*)(hb_ + (16 * pt + fr) * 128 + 32 * ks + 8 * G);
#pragma unroll
      for (int tt2 = 0; tt2 < 2; ++tt2)
#pragma unroll
          for (int pt = 0; pt < 4; ++pt) zpre[tt2][pt] = *(const u32x2*)((const bf16_t*)(p.ws + WS_PROJ) + (U.row0 + 16 * (2 * half_ + tt2) + fr) * NCD + 1536 + h_ * 64 + 16 * pt + 4 * G); }
    __syncthreads();
    const bf16_t* PROJ = (const bf16_t*)(p.ws + WS_PROJ); bf16_t* MIX = (bf16_t*)(p.ws + WS_MIX); const bf16_t* HIN = (const bf16_t*)p.out;
    const bf16_t* XT = (const bf16_t*)(lds + SL_XT); const bf16_t* BN = (const bf16_t*)(lds + SL_BN); const bf16_t* CN = (const bf16_t*)(lds + SL_CN);
    const float* dtl = (const float*)(lds + SL_DT); const float* cuml = (const float*)(lds + SL_CUM); float* CB = (float*)(lds + SL_CB); float* SS = (float*)(lds + SL_SS);
    for (int idx = wid; idx < 10; idx += 8) { const int tt = idx < 1 ? 0 : (idx < 3 ? 1 : (idx < 6 ? 2 : 3)), st = idx - (tt * (tt + 1)) / 2;
        f32x4 acc = (f32x4){0.f, 0.f, 0.f, 0.f};
#pragma unroll
        for (int ks = 0; ks < 4; ++ks) { const bf16x8 a = *(const bf16x8*)(BN + (16 * st + fr) * 136 + 32 * ks + 8 * G), bq = *(const bf16x8*)(CN + (16 * tt + fr) * 136 + 32 * ks + 8 * G); acc = MFMA16(a, bq, acc); }
        *(f32x4*)(CB + (16 * tt + fr) * 68 + 16 * st + 4 * G) = acc; }
    __syncthreads();
    const int hh = wid >> 1, half = wid & 1, h = U.g * 4 + hh;
    f32x4 acc1[2][4], acc2[2][4];
#pragma unroll
    for (int a = 0; a < 2; ++a)
#pragma unroll
        for (int b = 0; b < 4; ++b) { acc1[a][b] = (f32x4){0.f, 0.f, 0.f, 0.f}; acc2[a][b] = (f32x4){0.f, 0.f, 0.f, 0.f}; }
#pragma unroll
    for (int tt2 = 0; tt2 < 2; ++tt2) { const int ttile = 2 * half + tt2, t = 16 * ttile + fr; const float ct = cuml[hh * 64 + t];
#pragma unroll
        for (int ks = 0; ks < 2; ++ks) { if (32 * ks <= 16 * ttile + 15) { const int s0 = 32 * ks + 8 * G;
            const f32x4 cb0 = *(const f32x4*)(CB + t * 68 + s0), cb1 = *(const f32x4*)(CB + t * 68 + s0 + 4);
            const float4 d0 = *(const float4*)(dtl + hh * 64 + s0), d1 = *(const float4*)(dtl + hh * 64 + s0 + 4), c0 = *(const float4*)(cuml + hh * 64 + s0), c1 = *(const float4*)(cuml + hh * 64 + s0 + 4);
            float mm[8];
            mm[0] = (s0 + 0 <= t) ? cb0[0] * __expf(ct - c0.x) * d0.x : 0.f; mm[1] = (s0 + 1 <= t) ? cb0[1] * __expf(ct - c0.y) * d0.y : 0.f;
            mm[2] = (s0 + 2 <= t) ? cb0[2] * __expf(ct - c0.z) * d0.z : 0.f; mm[3] = (s0 + 3 <= t) ? cb0[3] * __expf(ct - c0.w) * d0.w : 0.f;
            mm[4] = (s0 + 4 <= t) ? cb1[0] * __expf(ct - c1.x) * d1.x : 0.f; mm[5] = (s0 + 5 <= t) ? cb1[1] * __expf(ct - c1.y) * d1.y : 0.f;
            mm[6] = (s0 + 6 <= t) ? cb1[2] * __expf(ct - c1.z) * d1.z : 0.f; mm[7] = (s0 + 7 <= t) ? cb1[3] * __expf(ct - c1.w) * d1.w : 0.f;
            const bf16x8 mb = as_bf16x8(PACK8(mm));
#pragma unroll
            for (int pt = 0; pt < 4; ++pt) { const bf16x8 a = *(const bf16x8*)(XT + (hh * 64 + 16 * pt + fr) * 72 + swz8(16 * pt + fr, s0)); acc1[tt2][pt] = MFMA16(a, mb, acc1[tt2][pt]); } } } }
    { const bf16_t* hb = HIN + ((size_t)U.cs * 8 + h) * 8192;
#pragma unroll
      for (int ks = 0; ks < 4; ++ks) { bf16x8 bq[2];
#pragma unroll
          for (int tt2 = 0; tt2 < 2; ++tt2) bq[tt2] = *(const bf16x8*)(CN + (16 * (2 * half + tt2) + fr) * 136 + 32 * ks + 8 * G);
#pragma unroll
          for (int pt = 0; pt < 4; ++pt) { bf16x8 a;
              if (U.smp) { const float* hf = p.state_ssm_d + ((size_t)U.b * 8 + h) * 8192 + (16 * pt + fr) * 128 + 32 * ks + 8 * G; const float4 x0 = *(const float4*)hf, x1 = *(const float4*)(hf + 4);
                  a = as_bf16x8((u32x4){pk2(x0.x, x0.y), pk2(x0.z, x0.w), pk2(x1.x, x1.y), pk2(x1.z, x1.w)}); }
              else a = hfr[ks][pt];
#pragma unroll
              for (int tt2 = 0; tt2 < 2; ++tt2) acc2[tt2][pt] = MFMA16(a, bq[tt2], acc2[tt2][pt]); } } }
    const float dsk = p.d_skip_d[h];
#pragma unroll
    for (int tt2 = 0; tt2 < 2; ++tt2) { const int t = 16 * (2 * half + tt2) + fr; const float et = __expf(cuml[hh * 64 + t]); float ss = 0.f;
#pragma unroll
        for (int pt = 0; pt < 4; ++pt) { const int pp = 16 * pt + 4 * G; const u32x2 zz = zpre[tt2][pt];
            const float zf[4] = {bflo(zz[0]), bfhi(zz[0]), bflo(zz[1]), bfhi(zz[1])};
#pragma unroll
            for (int r = 0; r < 4; ++r) { const float xv = bflo((unsigned)XT[(hh * 64 + pp + r) * 72 + swz8(pp + r, t)]); float y = acc1[tt2][pt][r] + et * acc2[tt2][pt][r] + dsk * xv; y *= silu_f(zf[r]); acc1[tt2][pt][r] = y; ss += y * y; } }
        ss += __shfl_xor(ss, 16); ss += __shfl_xor(ss, 32);
        if (G == 0) SS[hh * 64 + t] = ss; }
    __syncthreads();
#pragma unroll
    for (int tt2 = 0; tt2 < 2; ++tt2) { const int t = 16 * (2 * half + tt2) + fr; const float tot = SS[t] + SS[64 + t] + SS[128 + t] + SS[192 + t]; const float rstd = rsqrtf(tot * (1.f / 256.f) + 1e-5f);
#pragma unroll
        for (int pt = 0; pt < 4; ++pt) { const int pp = 16 * pt + 4 * G; const float4 ng = *(const float4*)(p.norm_g_d + h * 64 + pp);
            *(u32x2*)(MIX + (U.row0 + t) * DM + 512 + h * 64 + pp) = (u32x2){pk2(acc1[tt2][pt][0] * rstd * ng.x, acc1[tt2][pt][1] * rstd * ng.y), pk2(acc1[tt2][pt][2] * rstd * ng.z, acc1[tt2][pt][3] * rstd * ng.w)}; } }
    __syncthreads();
}

#ifndef REP9A
#define REP9A 0
#endif
#ifndef REP9S
#define REP9S 0
#endif
#ifndef REPM
#define REPM 0
#endif
#define PHASE(n, ...) if (p.ph_lo <= (n) && (n) < p.ph_hi) { if ((n) > p.ph_lo) { if (p.ph_hi > 1000) grid.sync(); else xcd_barrier(xb); } if (PHM & (1u << (n))) { __VA_ARGS__; } if (REPM & (1u << (n))) { __syncthreads(); __VA_ARGS__; } }
#define PHASER(n, rep, ...) if (p.ph_lo <= (n) && (n) < p.ph_hi) { if ((n) > p.ph_lo) { if ((n) == 1) grid.sync(); else xcd_barrier(xb); } if (PHM & (1u << (n))) { __VA_ARGS__; } if (REPM & (1u << (n))) { __syncthreads(); rep; } }
__global__ void __launch_bounds__(512, 2) mega(Params p) {
    extern __shared__ __attribute__((aligned(16))) unsigned char lds[];
    cg::grid_group grid = cg::this_grid();
    volatile LAS unsigned* xst = (volatile LAS unsigned*)((LAS unsigned char*)lds + 131072);
    if (threadIdx.x < 4) xst[threadIdx.x] = 0u;
    __syncthreads();
    const XcdBarrier xb = xcd_barrier_post((unsigned*)(p.ws + WS_BAR), xst);
    bf16_t* HB = (bf16_t*)(p.ws + WS_XN); bf16_t* PROJ = (bf16_t*)(p.ws + WS_PROJ); bf16_t* MIX = (bf16_t*)(p.ws + WS_MIX);
    ssq_t* SS0 = (ssq_t*)(p.ws + WS_SS); ssq_t* SS1 = SS0 + MT; ssq_t* SS2 = SS1 + MT; ssq_t* SS3 = SS2 + MT; ssq_t* SS4 = SS3 + MT; float* DTB = (float*)(p.ws + WS_DT);
    const bf16_t* WGU = (const bf16_t*)(p.ws + WS_WT_GU); const bf16_t* WDN = (const bf16_t*)(p.ws + WS_WT_DN);
    const bf16_t* WINAB = (const bf16_t*)(p.ws + WS_WT_INAB); const bf16_t* WOUTAB = (const bf16_t*)(p.ws + WS_WT_OUTAB); const bf16_t* WINCD = (const bf16_t*)(p.ws + WS_WT_INCD); const bf16_t* WOUTCD = (const bf16_t*)(p.ws + WS_WT_OUTCD);
#ifdef EXTRA_SYNC
    for (int i = 0; i < EXTRA_SYNC; ++i) xcd_barrier(xb);
#endif
    PHASE(0, phase_prep(p, lds); phase_convert_x(p))
    PHASE(1, run_gemm(lds, HB, WINAB, NAB, DM, EpiProjAB{PROJ, SS0}); small_gemm<0>(p, lds, HB, WINAB, DM, NAB / 64, SS0, nullptr, nullptr, nullptr))
    PHASE(2, phase_mixer_ab(p, lds))
    PHASE(3, run_gemm(lds, MIX, WOUTAB, DM, DM, EpiRes{HB, p.x_prompt, SS1}); small_gemm<1>(p, lds, MIX, WOUTAB, DM, DM / 64, nullptr, HB, p.x_sample, SS1))
    PHASE(5, run_gemm(lds, HB, WGU, 2 * FH, DM, EpiSwiglu{PROJ, SS1}); small_gemm<2>(p, lds, HB, WGU, DM, FH / 32, SS1, nullptr, nullptr, nullptr))
    PHASE(6, run_gemm(lds, PROJ, WDN, DM, FH, EpiRes{HB, nullptr, SS2}); small_gemm<1>(p, lds, PROJ, WDN, FH, DM / 64, nullptr, HB, nullptr, SS2))
    PHASE(8, run_gemm(lds, HB, WINCD, NCDP, DM, EpiProjCD{PROJ, p.out, SS2, DTB}); small_gemm<3>(p, lds, HB, WINCD, DM, NCD / 64 + 1, SS2, nullptr, nullptr, nullptr))
    PHASE(9, { int u = blockIdx.x;
        { u32x4 rws[11]; ssd_rows_load(p, ssd_decode(u < N_SSD ? u : 0), rws);
          for (; u < N_SSD; u += gridDim.x) { const int vn = u + (int)gridDim.x < N_SSD ? u + (int)gridDim.x : u; ssd_state_unit(p, lds, u, vn, rws); } }
        for (; u < N_SSD + N_ATT; u += gridDim.x) { const int a = u - N_SSD; const int w = a < N_ATT_P ? ((a & 7) * 256 + (a >> 3)) : a; att_unit(p, lds, w); }
        for (; u < N_SSD + N_ATT + 16; u += gridDim.x) { u32x4 rws[11]; ssd_out_unit<false>(p, lds, 2048 + (u - N_SSD - N_ATT), 0, rws); } })
    PHASE(10, phase_scan(p))
    PHASE(11, { u32x4 rws[11]; int u = blockIdx.x; ssd_rows_load(p, ssd_decode(u < 2048 ? u : 0), rws);
        for (; u < 2048; u += gridDim.x) { const int un = u + (int)gridDim.x < 2048 ? u + (int)gridDim.x : u; ssd_out_unit<true>(p, lds, u, un, rws); } })
    PHASE(12, run_gemm(lds, MIX, WOUTCD, DM, DM, EpiRes{HB, nullptr, SS3}); small_gemm<1>(p, lds, MIX, WOUTCD, DM, DM / 64, nullptr, HB, nullptr, SS3))
    PHASE(14, run_gemm(lds, HB, WGU + (size_t)2 * FH * DM, 2 * FH, DM, EpiSwiglu{PROJ, SS3}); small_gemm<2>(p, lds, HB, WGU + (size_t)2 * FH * DM, DM, FH / 32, SS3, nullptr, nullptr, nullptr))
    PHASE(15, run_gemm(lds, PROJ, WDN + (size_t)DM * FH, DM, FH, EpiRes{HB, nullptr, SS4}); small_gemm<1>(p, lds, PROJ, WDN + (size_t)DM * FH, FH, DM / 64, nullptr, HB, nullptr, SS4))
    PHASE(16, phase_final_norm(p))
}

extern "C" void kernel_launch(void* const* d_in, const int* in_sizes, int n_in, void* d_out, int out_size, void* d_ws, size_t ws_size, hipStream_t stream) {
    static int grid = 0;
    if (grid == 0) {
        int dev = 0, cus = 0, per_cu = 0;
        hipGetDevice(&dev); hipDeviceGetAttribute(&cus, hipDeviceAttributeMultiprocessorCount, dev);
        if (hipFuncSetAttribute((const void*)mega, hipFuncAttributeMaxDynamicSharedMemorySize, LDS_BYTES) != hipSuccess) fprintf(stderr, "kernel_launch: hipFuncSetAttribute failed\n");
        if (hipOccupancyMaxActiveBlocksPerMultiprocessor(&per_cu, (const void*)mega, 512, LDS_BYTES) != hipSuccess || per_cu < 1) { fprintf(stderr, "kernel_launch: occupancy query gave %d\n", per_cu); per_cu = 1; }
        (void)hipGetLastError();
        if (cus <= 0) cus = 256;
        grid = cus;
        if (n_in != 29 || (size_t)out_size != O_END || ws_size < WS_END) fprintf(stderr, "kernel_launch: unexpected sizes n_in %d out %d ws %zu (need %zu)\n", n_in, out_size, ws_size, (size_t)WS_END);
    }
    Params p{};
    const float** pp = (const float**)&p;
    for (int i = 0; i < 29; ++i) pp[i] = (const float*)d_in[i];
    p.out = (float*)d_out; p.ws = (unsigned char*)d_ws;
    if (hipMemsetAsync((unsigned char*)d_ws + WS_BAR, 0, 16384, stream) != hipSuccess) fprintf(stderr, "kernel_launch: memset of the barrier words failed\n");
#if PER_PHASE_LAUNCH
    for (int ph = 0; ph < NPH; ++ph) { p.ph_lo = ph; p.ph_hi = ph + 1; hipLaunchKernelGGL(mega, dim3(grid), dim3(512), LDS_BYTES, stream, p); }
#else
    p.ph_lo = 0; p.ph_hi = NPH; void* args[] = {&p};
    hipError_t e = hipLaunchCooperativeKernel((const void*)mega, dim3(grid), dim3(512), args, LDS_BYTES, stream);
    if (e != hipSuccess) fprintf(stderr, "kernel_launch: cooperative launch failed: %s (grid %d)\n", hipGetErrorString(e), grid);
#endif
}
```
